# Optimizing an MI355X kernel written in HIP

```python
import jax, jax.numpy as jnp
from jax import lax
import numpy as np

D_MODEL = 1024
BATCH = 16
SEQ = 2048
DEPTH = 2

GRID_W = 64
CTX_LEN = 256
EPS = 1e-6
N_MOD = 9

D_FF = 2816

A_HEADS = 8
A_HEAD_DIM = 64
A_WIDTH = A_HEADS * A_HEAD_DIM
WIN_R = 8
WIN_C = 16
COL_BLOCK = 16
COL_BAND = COL_BLOCK + WIN_C

POOL_WINDOWS = (2, 4, 8, 16)
B_WIDTH = D_MODEL - A_WIDTH
B_GROUP = B_WIDTH // len(POOL_WINDOWS)

HG_EXPAND = 128
HG_HEADS = D_MODEL // HG_EXPAND
HG_DK = HG_EXPAND
HG_DV = D_MODEL // HG_HEADS
HG_KDIM = HG_HEADS * HG_DK
HG_VDIM = HG_HEADS * HG_DV
HG_CHUNK = 32

kernel_name = "hybrid_natten_pool_hgrn2_diffusion_block"


def rms_norm(x, g):
    xf = x.astype(jnp.float32)
    y = xf * lax.rsqrt(jnp.mean(xf * xf, axis=-1, keepdims=True) + EPS)
    return (y * g.astype(jnp.float32)).astype(x.dtype)


def adaln_in(h, g, shift, scale):
    return rms_norm(h, g) * (1 + scale) + shift


def swiglu(h, w13, w2):
    a, b = jnp.split(h @ w13, 2, axis=-1)
    return (jax.nn.silu(a) * b) @ w2


def neighbourhood_attention(q, k, v, k_ctx, v_ctx, rpb):
    bsz, n, nh, dh = q.shape
    rows = n // GRID_W
    kr = min(WIN_R, rows)
    ncb = GRID_W // COL_BLOCK
    scale = dh ** -0.5
    qg = q.reshape(bsz, rows, ncb, COL_BLOCK, nh, dh)
    kg = k.reshape(bsz, rows, GRID_W, nh, dh)
    vg = v.reshape(bsz, rows, GRID_W, nh, dh)
    col_q = jnp.arange(GRID_W).reshape(ncb, COL_BLOCK)
    win_c0 = jnp.clip(col_q - WIN_C // 2, 0, GRID_W - WIN_C)
    band0 = jnp.clip(jnp.arange(ncb) * COL_BLOCK - WIN_C // 2, 0, GRID_W - COL_BAND)
    key_col = band0[:, None] + jnp.arange(COL_BAND)
    kc = key_col[:, None, :]
    col_ok = (kc >= win_c0[:, :, None]) & (kc < win_c0[:, :, None] + WIN_C)
    rel_c = jnp.clip(kc - col_q[:, :, None], -(WIN_C - 1), WIN_C - 1) + (WIN_C - 1)
    rpb_c = rpb[:, :, rel_c]
    nloc = kr * COL_BAND

    def row_block(r):
        r0 = jnp.clip(r - kr // 2, 0, rows - kr)
        key_rows = r0 + jnp.arange(kr)
        k_band = jnp.take(kg, key_rows, axis=1)[:, :, key_col]
        v_band = jnp.take(vg, key_rows, axis=1)[:, :, key_col]
        q_blk = lax.dynamic_index_in_dim(qg, r, axis=1, keepdims=False)
        s_loc = jnp.einsum('bnqhd,bjnkhd->bhnqjk', q_blk, k_band).astype(jnp.float32) * scale
        bias = rpb_c[:, key_rows - r + (WIN_R - 1)].transpose(0, 2, 3, 1, 4)
        s_loc = s_loc + bias[None].astype(jnp.float32)
        s_loc = jnp.where(col_ok[:, :, None, :], s_loc, -jnp.inf)
        s_loc = s_loc.reshape(bsz, nh, ncb, COL_BLOCK, nloc)
        s_ctx = jnp.einsum('bnqhd,bchd->bhnqc', q_blk, k_ctx).astype(jnp.float32) * scale
        p = jax.nn.softmax(jnp.concatenate([s_loc, s_ctx], axis=-1), axis=-1).astype(v.dtype)
        p_loc = p[..., :nloc].reshape(bsz, nh, ncb, COL_BLOCK, kr, COL_BAND)
        p_ctx = p[..., nloc:]
        return (jnp.einsum('bhnqjk,bjnkhd->bnqhd', p_loc, v_band)
                + jnp.einsum('bhnqc,bchd->bnqhd', p_ctx, v_ctx))

    out = lax.map(row_block, jnp.arange(rows))
    return out.transpose(1, 0, 2, 3, 4, 5).reshape(bsz, n, nh * dh)


def context_attention(q, k, v):
    bsz, L, nh, dh = q.shape
    s = jnp.einsum('bqhd,bkhd->bhqk', q, k).astype(jnp.float32) * (dh ** -0.5)
    p = jax.nn.softmax(s, axis=-1).astype(v.dtype)
    return jnp.einsum('bhqk,bkhd->bqhd', p, v).reshape(bsz, L, nh * dh)


def centred_pool_minus_self(u, w):
    bsz, L, ch = u.shape
    t = jnp.arange(L)
    lo = jnp.clip(t - w // 2, 0, L)
    hi = jnp.clip(t - w // 2 + w, 0, L)
    uf = u.astype(jnp.float32)
    cs = jnp.concatenate([jnp.zeros((bsz, 1, ch), jnp.float32), jnp.cumsum(uf, axis=1)], axis=1)
    mean = (cs[:, hi] - cs[:, lo]) / (hi - lo).astype(jnp.float32)[None, :, None]
    return (mean - uf).astype(u.dtype)


def pool_mixer(u, pool_w, pool_scale):
    bsz, L, _ = u.shape
    groups = jnp.split(u, len(POOL_WINDOWS), axis=-1)
    d = jnp.stack([centred_pool_minus_self(gi, w) for gi, w in zip(groups, POOL_WINDOWS)], axis=2)
    y = jnp.einsum('blgc,gcd->blgd', d, pool_w).reshape(bsz, L, B_WIDTH)
    return y * pool_scale


def ab_mixer(x_lat, x_ctx, w_in, rpb, pool_w, pool_scale, w_out, need_ctx_out):
    def split(p):
        bsz, L, _ = p.shape
        q, k, v, u = jnp.split(p, [A_WIDTH, 2 * A_WIDTH, 3 * A_WIDTH], axis=-1)
        heads = lambda t: t.reshape(bsz, L, A_HEADS, A_HEAD_DIM)
        return heads(q), heads(k), heads(v), u

    q_l, k_l, v_l, u_l = split(x_lat @ w_in)
    q_c, k_c, v_c, u_c = split(x_ctx @ w_in)
    a_l = neighbourhood_attention(q_l, k_l, v_l, k_c, v_c, rpb)
    y_l = jnp.concatenate([a_l, pool_mixer(u_l, pool_w, pool_scale)], axis=-1) @ w_out
    if not need_ctx_out:
        return y_l, None
    a_c = context_attention(q_c, k_c, v_c)
    y_c = jnp.concatenate([a_c, pool_mixer(u_c, pool_w, pool_scale)], axis=-1) @ w_out
    return y_l, y_c


def gla_chunk_scan(q, k, v, logf, s0, reverse):
    if reverse:
        q, k, v, logf = (jnp.flip(t, axis=1) for t in (q, k, v, logf))
    bsz, L, nh, _ = q.shape
    nc = L // HG_CHUNK
    to_chunks = lambda t: t.reshape(bsz, nc, HG_CHUNK, nh, t.shape[-1]).transpose(1, 0, 3, 2, 4)
    causal = jnp.tril(jnp.ones((HG_CHUNK, HG_CHUNK), dtype=bool))[:, :, None]

    def step(s, xs):
        qi, ki, vi, gi = xs
        G = jnp.cumsum(gi, axis=2)
        o_inter = jnp.einsum('bhtk,bhkv->bhtv', qi * jnp.exp(G), s)
        diff = G[:, :, :, None, :] - G[:, :, None, :, :]
        decay = jnp.exp(jnp.where(causal, diff, -jnp.inf))
        a = jnp.einsum('bhtk,bhsk,bhtsk->bhts', qi, ki, decay)
        o = o_inter + jnp.einsum('bhts,bhsv->bhtv', a, vi)
        g_last = G[:, :, -1:, :]
        s_new = (jnp.exp(g_last[:, :, 0, :, None]) * s
                 + jnp.einsum('bhsk,bhsv->bhkv', ki * jnp.exp(g_last - G), vi))
        return s_new, o

    s_fin, o = lax.scan(step, s0, (to_chunks(q), to_chunks(k), to_chunks(v), to_chunks(logf)))
    o = o.transpose(1, 0, 3, 2, 4).reshape(bsz, L, nh, HG_DV)
    if reverse:
        o = jnp.flip(o, axis=1)
    return o, s_fin


def hg_project(x, w_in, lower_bounds):
    bsz, L, _ = x.shape
    p = (x @ w_in).astype(jnp.float32)
    q, i, f_fw, f_bw, g = jnp.split(
        p, [HG_KDIM, HG_KDIM + HG_VDIM, 2 * HG_KDIM + HG_VDIM, 3 * HG_KDIM + HG_VDIM], axis=-1)
    hk = lambda t: t.reshape(bsz, L, HG_HEADS, HG_DK)
    lb = lower_bounds.astype(jnp.float32)
    forget = [hk(lb[d] + (1.0 - lb[d]) * jax.nn.sigmoid(f)) for d, f in enumerate((f_fw, f_bw))]
    return hk(jax.nn.silu(q)), i.reshape(bsz, L, HG_HEADS, HG_DV), forget, g


def hg_readout(o, g, gnorm, w_out, dtype):
    bsz, L = o.shape[:2]
    o = o * lax.rsqrt(jnp.mean(o * o, axis=-1, keepdims=True) + EPS) * gnorm.astype(jnp.float32)
    o = o.reshape(bsz, L, HG_VDIM) * jax.nn.silu(g)
    return o.astype(dtype) @ w_out


def hg_mixer(x_lat, x_ctx, w_in, lower_bounds, gnorm, w_out, need_ctx_out):
    q_l, i_l, f_l, g_l = hg_project(x_lat, w_in, lower_bounds)
    q_c, i_c, f_c, g_c = hg_project(x_ctx, w_in, lower_bounds)
    bsz = x_lat.shape[0]
    outs_l, outs_c = [], []
    for d in range(2):
        rev = d == 1
        s0 = jnp.zeros((bsz, HG_HEADS, HG_DK, HG_DV), jnp.float32)
        o_c, s_ctx = gla_chunk_scan(q_c, 1.0 - f_c[d], i_c, jnp.log(f_c[d]), s0, rev)
        o_l, _ = gla_chunk_scan(q_l, 1.0 - f_l[d], i_l, jnp.log(f_l[d]), s_ctx, rev)
        outs_l.append(o_l)
        outs_c.append(o_c)
    y_l = hg_readout(outs_l[0] + outs_l[1], g_l, gnorm, w_out, x_lat.dtype)
    if not need_ctx_out:
        return y_l, None
    return y_l, hg_readout(outs_c[0] + outs_c[1], g_c, gnorm, w_out, x_ctx.dtype)


def setup_inputs(seed: int = 0) -> dict:
    key = jax.random.key(seed)
    ks = jax.random.split(key, 19)
    D = D_MODEL
    n_even = (DEPTH + 1) // 2
    n_odd = DEPTH // 2
    f32 = jnp.float32
    nrm = lambda k, shape: jax.random.normal(k, shape, f32)
    return {
        "x": nrm(ks[0], (BATCH, SEQ, D)),
        "c": nrm(ks[1], (BATCH, D)),
        "ctx": nrm(ks[2], (BATCH, CTX_LEN, D)),
        "c_ctx": nrm(ks[3], (D,)),
        "w_mod": nrm(ks[4], (DEPTH, D, N_MOD * D)) * (0.5 * D ** -0.5),
        "b_mod": nrm(ks[5], (DEPTH, N_MOD * D)) * 0.02,
        "norm_g": 1.0 + 0.1 * nrm(ks[6], (DEPTH, 3, D)),
        "ffn_w13": nrm(ks[7], (DEPTH, 2, D, 2 * D_FF)) * D ** -0.5,
        "ffn_w2": nrm(ks[8], (DEPTH, 2, D_FF, D)) * D_FF ** -0.5,
        "ab_w_in": nrm(ks[9], (n_even, D, 3 * A_WIDTH + B_WIDTH)) * D ** -0.5,
        "ab_rpb": 0.5 * nrm(ks[10], (n_even, A_HEADS, 2 * WIN_R - 1, 2 * WIN_C - 1)),
        "ab_pool_w": nrm(ks[11], (n_even, len(POOL_WINDOWS), B_GROUP, B_GROUP)) * B_GROUP ** -0.5,
        "ab_pool_scale": 1.0 + 0.1 * nrm(ks[12], (n_even, B_WIDTH)),
        "ab_w_out": nrm(ks[13], (n_even, A_WIDTH + B_WIDTH, D)) * (A_WIDTH + B_WIDTH) ** -0.5,
        "hg_w_in": nrm(ks[14], (n_odd, D, 3 * HG_KDIM + 2 * HG_VDIM)) * D ** -0.5,
        "hg_lb_logits": 0.5 * nrm(ks[15], (DEPTH, 2, HG_KDIM)),
        "hg_gnorm": 1.0 + 0.1 * nrm(ks[16], (n_odd, HG_DV)),
        "hg_w_out": nrm(ks[17], (n_odd, HG_VDIM, D)) * HG_VDIM ** -0.5,
        "final_g": 1.0 + 0.1 * nrm(ks[18], (D,)),
    }


def reference(x, c, ctx, c_ctx, w_mod, b_mod, norm_g, ffn_w13, ffn_w2, ab_w_in, ab_rpb, ab_pool_w,
              ab_pool_scale, ab_w_out, hg_w_in, hg_lb_logits, hg_gnorm, hg_w_out, final_g):
    sm = jax.nn.softmax(hg_lb_logits.astype(jnp.float32), axis=0)
    lb_all = jnp.cumsum(sm, axis=0) - sm[0:1]
    silu_c = jax.nn.silu(c)
    silu_cc = jax.nn.silu(c_ctx)
    h_lat, h_ctx = x, ctx
    for l in range(DEPTH):
        last = l == DEPTH - 1
        ml = jnp.split((silu_c @ w_mod[l] + b_mod[l])[:, None, :], N_MOD, axis=-1)
        mc = jnp.split(silu_cc @ w_mod[l] + b_mod[l], N_MOD, axis=-1)
        h_lat = h_lat + 0.5 * ml[2] * swiglu(adaln_in(h_lat, norm_g[l, 0], ml[0], ml[1]), ffn_w13[l, 0], ffn_w2[l, 0])
        h_ctx = h_ctx + 0.5 * mc[2] * swiglu(adaln_in(h_ctx, norm_g[l, 0], mc[0], mc[1]), ffn_w13[l, 0], ffn_w2[l, 0])
        xl = adaln_in(h_lat, norm_g[l, 1], ml[3], ml[4])
        xc = adaln_in(h_ctx, norm_g[l, 1], mc[3], mc[4])
        j = l // 2
        if l % 2 == 0:
            y_lat, y_ctx = ab_mixer(xl, xc, ab_w_in[j], ab_rpb[j], ab_pool_w[j], ab_pool_scale[j], ab_w_out[j],
                                    not last)
        else:
            y_lat, y_ctx = hg_mixer(xl, xc, hg_w_in[j], lb_all[l], hg_gnorm[j], hg_w_out[j], not last)
        h_lat = h_lat + ml[5] * y_lat
        h_lat = h_lat + 0.5 * ml[8] * swiglu(adaln_in(h_lat, norm_g[l, 2], ml[6], ml[7]), ffn_w13[l, 1], ffn_w2[l, 1])
        if not last:
            h_ctx = h_ctx + mc[5] * y_ctx
            h_ctx = h_ctx + 0.5 * mc[8] * swiglu(adaln_in(h_ctx, norm_g[l, 2], mc[6], mc[7]), ffn_w13[l, 1],
                                                 ffn_w2[l, 1])
    return rms_norm(h_lat, final_g)
```

```cpp
#include <hip/hip_runtime.h>
#include <hip/hip_cooperative_groups.h>
#include <cstdio>
namespace cg = cooperative_groups;

#ifndef MK_PER_PHASE
#define MK_PER_PHASE 0
#endif

namespace pg8 {
#define PG8_LAS __attribute__((address_space(3)))
typedef unsigned short bf16_t;
typedef short bf16x8 __attribute__((ext_vector_type(8)));
typedef float f32x4 __attribute__((ext_vector_type(4)));
typedef unsigned u32x4 __attribute__((ext_vector_type(4)));
constexpr int BM = 256, BK = 64, HALF = 128, HTB = HALF * BK * 2  , STAGE_BYTES = 8 * HTB, NXCD = 8, WGM = 8;

__host__ __device__ __forceinline__ int lds_byte(int r, int c) { const int st = (r >> 4) * 2 + (c >> 5), rr = r & 15, cc = c & 31, ob = rr * 64 + cc * 2; return st * 1024 + (ob ^ (((ob >> 9) & 1) << 5)); }
__host__ __device__ __forceinline__ void stage_rc(int b, int& R, int& C) { const int st = b / 1024, sb = b % 1024, swz = sb ^ (((sb >> 9) & 1) << 5); R = (st >> 1) * 16 + swz / 64; C = (st & 1) * 32 + (swz % 64) / 2; }
__host__ __device__ __forceinline__ int perm32(int rho) { const int n = rho >> 4, i = rho & 15; return 8 * (i >> 2) + 4 * n + (i & 3); }

struct Unit { int pm, pn; };
struct Gemm { const bf16_t* A; const bf16_t* Bt; int M, N, K; };

struct StaticOrder {
    int nM, nN, nwg, G, c;
    __host__ __device__ void init(int M, int N, int G_, int c_) { nM = M / BM; nN = N / BM; nwg = nM * nN; G = G_; c = c_; }
    __host__ __device__ bool next(int i, Unit& u) const {
        const long L = (long)i * G + c; if (L >= nwg) return false;
        int wgid = (int)L; { const int q = nwg / NXCD, r = nwg % NXCD, xcd = wgid % NXCD, off = wgid / NXCD; wgid = (xcd < r ? xcd * (q + 1) : r * (q + 1) + (xcd - r) * q) + off; }
        const int nig = WGM * nN, gid = wgid / nig, fm = gid * WGM, gsz = (nM - fm) < WGM ? (nM - fm) : WGM;
        u.pm = fm + ((wgid % nig) % gsz); u.pn = (wgid % nig) / gsz; return true;
    }
    __device__ __forceinline__ void a_ready(const Unit&) const {}
    __device__ __forceinline__ void done(const Unit&) const {}
};

template <class Epi, class Sched, bool STAMP = false>
__device__ __forceinline__ void gemm_phase(PG8_LAS unsigned char* lds, const Gemm g, const Sched& S, const Epi& E, unsigned long long* stamps) {
    const int tid = threadIdx.x, wid = __builtin_amdgcn_readfirstlane(tid >> 6), lane = tid & 63, wr = wid >> 2, wc = wid & 3, fr = lane & 15, fq = lane >> 4;
    const int K = g.K, nt = K / BK;
    int ts_lo = 0, ts_hi = 0, nts = 0; const unsigned long long rt_entry = STAMP ? (unsigned long long)wall_clock64() : 0ull;
#define PG8_STAMP() do { if (STAMP && wid == 0 && nts < 64) { const unsigned long long _c = (unsigned long long)clock64(); \
        ts_lo = (lane == nts) ? (int)(unsigned)_c : ts_lo; ts_hi = (lane == nts) ? (int)(unsigned)(_c >> 32) : ts_hi; ++nts; } } while (0)
    PG8_STAMP();
    unsigned voffA[2], voffB[2];
#pragma unroll
    for (int i = 0; i < 2; ++i) { int R, C; stage_rc(tid * 16 + i * 8192, R, C); const int Rb = Epi::PERM ? ((R & ~31) + perm32(R & 31)) : R;
        voffA[i] = (unsigned)(R * K + C) * 2u; voffB[i] = (unsigned)(Rb * K + C) * 2u; }
    const size_t kstep = (size_t)(BK * 2);
    const size_t hstep = (size_t)HALF * K * 2;
    const size_t tstep = 2 * hstep;
    const unsigned ldsw = (unsigned)wid * 1024u;
    const int aoff = lds_byte(wr * 64 + fr, fq * 8), boff = lds_byte(wc * 32 + fr, fq * 8);
#define PG8_SA(b, h) (((b) * 2 + (h)) * HTB)
#define PG8_SB(b, h) ((4 + (b) * 2 + (h)) * HTB)
#define PG8_STAGE(bufoff, gbase, voff) do { _Pragma("unroll") for (int _i = 0; _i < 2; ++_i) \
        __builtin_amdgcn_global_load_lds((const unsigned*)((const char*)(gbase) + (voff)[_i]), (PG8_LAS unsigned*)(lds + (bufoff) + ldsw + _i * 8192), 16, 0, 0); } while (0)
#define PG8_LDA(dst, b, h) do { _Pragma("unroll") for (int m = 0; m < 4; ++m) _Pragma("unroll") for (int k = 0; k < 2; ++k) dst[m][k] = *(const PG8_LAS bf16x8*)(lds + PG8_SA(b, h) + aoff + m * 2048 + k * 1024); } while (0)
#define PG8_LDB(dst, b, h) do { _Pragma("unroll") for (int n = 0; n < 2; ++n) _Pragma("unroll") for (int k = 0; k < 2; ++k) dst[n][k] = *(const PG8_LAS bf16x8*)(lds + PG8_SB(b, h) + boff + n * 2048 + k * 1024); } while (0)
#define PG8_MMA(ai, bj, At, Bt) do { __builtin_amdgcn_s_setprio(1); _Pragma("unroll") for (int m = 0; m < 4; ++m) _Pragma("unroll") for (int n = 0; n < 2; ++n) _Pragma("unroll") for (int k = 0; k < 2; ++k) \
        acc[ai][bj][m][n] = __builtin_amdgcn_mfma_f32_16x16x32_bf16(Bt[n][k], At[m][k], acc[ai][bj][m][n], 0, 0, 0); __builtin_amdgcn_s_setprio(0); } while (0)
#define PG8_WAIT_V(n) asm volatile("s_waitcnt vmcnt(" #n ")" ::: "memory")
#define PG8_WAIT_L(n) asm volatile("s_waitcnt lgkmcnt(" #n ")" ::: "memory")
#define PG8_BAR __builtin_amdgcn_s_barrier()
#define PG8_SCHED __builtin_amdgcn_sched_barrier(0)
    Unit cur, nxt; int ui = 0;
    if (!S.next(0, cur)) return;
    f32x4 acc[2][2][4][2];
#pragma unroll
    for (int a = 0; a < 2; ++a)
#pragma unroll
        for (int b = 0; b < 2; ++b)
#pragma unroll
            for (int m = 0; m < 4; ++m)
#pragma unroll
                for (int n = 0; n < 2; ++n) acc[a][b][m][n] = (f32x4){0.f, 0.f, 0.f, 0.f};
    bf16x8 At[4][2], B0[2][2], B1[2][2];
    const char* cA = (const char*)g.A + (size_t)cur.pm * tstep; const char* cB = (const char*)g.Bt + (size_t)cur.pn * tstep;
    S.a_ready(cur);
    PG8_STAGE(PG8_SB(0, 0), cB, voffB); PG8_STAGE(PG8_SA(0, 0), cA, voffA); PG8_STAGE(PG8_SB(0, 1), cB + hstep, voffB); PG8_STAGE(PG8_SA(0, 1), cA + hstep, voffA);
    if (wr == 1) PG8_BAR;
    PG8_WAIT_V(4); PG8_BAR;
    PG8_STAGE(PG8_SB(1, 0), cB + kstep, voffB); PG8_STAGE(PG8_SA(1, 0), cA + kstep, voffA); PG8_STAGE(PG8_SB(1, 1), cB + hstep + kstep, voffB);
    PG8_WAIT_V(6); PG8_BAR;
    PG8_STAMP();
    for (;;) {
        const bool has_next = S.next(ui + 1, nxt);
        const char* nA = has_next ? (const char*)g.A + (size_t)nxt.pm * tstep : cA; const char* nB = has_next ? (const char*)g.Bt + (size_t)nxt.pn * tstep : cB;
        for (int t = 0; t < nt; t += 2) {
            const bool last = (t == nt - 2);
            const char* a1 = cA + (size_t)(t + 1) * kstep;
            const char* a2 = last ? nA : cA + (size_t)(t + 2) * kstep; const char* b2 = last ? nB : cB + (size_t)(t + 2) * kstep;
            const char* a3 = a2 + kstep; const char* b3 = b2 + kstep;
            if (last && has_next) S.a_ready(nxt);
            PG8_LDB(B0, 0, 0); PG8_SCHED; PG8_LDA(At, 0, 0); PG8_STAGE(PG8_SA(1, 1), a1 + hstep, voffA);
            PG8_WAIT_L(8); PG8_BAR; PG8_WAIT_L(0); PG8_MMA(0, 0, At, B0); PG8_BAR; PG8_SCHED;
            PG8_LDB(B1, 0, 1); PG8_STAGE(PG8_SB(0, 0), b2, voffB);
            PG8_BAR; PG8_WAIT_L(0); PG8_MMA(0, 1, At, B1); PG8_BAR;
            PG8_LDA(At, 0, 1); PG8_STAGE(PG8_SA(0, 0), a2, voffA);
            PG8_BAR; PG8_WAIT_L(0); PG8_MMA(1, 0, At, B0); PG8_BAR; PG8_SCHED;
            PG8_STAGE(PG8_SB(0, 1), b2 + hstep, voffB);
            PG8_WAIT_V(6); PG8_BAR; PG8_MMA(1, 1, At, B1); PG8_BAR;
            PG8_LDB(B0, 1, 0); PG8_SCHED; PG8_LDA(At, 1, 0); PG8_STAGE(PG8_SA(0, 1), a2 + hstep, voffA);
            PG8_WAIT_L(8); PG8_BAR; PG8_WAIT_L(0); PG8_MMA(0, 0, At, B0); PG8_BAR; PG8_SCHED;
            PG8_LDB(B1, 1, 1); PG8_STAGE(PG8_SB(1, 0), b3, voffB);
            PG8_BAR; PG8_WAIT_L(0); PG8_MMA(0, 1, At, B1); PG8_BAR;
            PG8_LDA(At, 1, 1); PG8_STAGE(PG8_SA(1, 0), a3, voffA);
            PG8_BAR; PG8_WAIT_L(0); PG8_MMA(1, 0, At, B0); PG8_BAR; PG8_SCHED;
            PG8_STAGE(PG8_SB(1, 1), b3 + hstep, voffB);
            PG8_WAIT_V(6); PG8_BAR; PG8_MMA(1, 1, At, B1); PG8_BAR;
        }
        PG8_STAMP();
        if constexpr (!Epi::AFTER_DRAIN) { E(acc, cur, wr, wc, fr, fq); S.done(cur); }
        PG8_STAMP();
        if (!has_next) break;
#pragma unroll
        for (int a = 0; a < 2; ++a)
#pragma unroll
            for (int b = 0; b < 2; ++b)
#pragma unroll
                for (int m = 0; m < 4; ++m)
#pragma unroll
                    for (int n = 0; n < 2; ++n) acc[a][b][m][n] = (f32x4){0.f, 0.f, 0.f, 0.f};
        cur = nxt; cA = nA; cB = nB; ++ui;
    }
    PG8_WAIT_V(0);
    if (wr == 0) PG8_BAR;
    PG8_BAR;
    if constexpr (Epi::AFTER_DRAIN) { E.fused(acc, cur, wr, wc, fr, fq, lds, wid, lane); S.done(cur); }
    PG8_STAMP();
    if (STAMP && wid == 0) { stamps[lane] = lane < nts ? (((unsigned long long)(unsigned)ts_hi << 32) | (unsigned)ts_lo) : 0ull;
        if (lane == 62) stamps[62] = rt_entry; if (lane == 63) stamps[63] = (unsigned long long)wall_clock64(); }
#undef PG8_STAMP
#undef PG8_SA
#undef PG8_SB
#undef PG8_STAGE
#undef PG8_LDA
#undef PG8_LDB
#undef PG8_MMA
#undef PG8_WAIT_V
#undef PG8_WAIT_L
#undef PG8_BAR
#undef PG8_SCHED
}
}

namespace mk {
using pg8::bf16_t; using pg8::bf16x8; using pg8::f32x4; using pg8::u32x4;
typedef unsigned u32x2 __attribute__((ext_vector_type(2)));

constexpr int D = 1024, NB = 16, SEQ = 2048, CTXL = 256, NLAT = NB * SEQ, NCTX = NB * CTXL, T = NLAT + NCTX, DFF = 2816;
constexpr int NMOD = 9 * 1024;
constexpr float EPS = 1e-6f;
constexpr int LDS_BYTES = 131072;
constexpr int NPHASE = 23;

constexpr size_t MiB = (size_t)1 << 20;
constexpr size_t WS_BT = 0, WS_HCTX = 48 * MiB, WS_XN = 64 * MiB, WS_SMALL = 136 * MiB, WS_BIG = 144 * MiB, WS_END = 504 * MiB;
constexpr size_t BT_W13A = 0, BT_W2A = 5767168, BT_MIXIN = 8650752, BT_MIXOUT = 13893632, BT_W13B = 14942208, BT_W2B = 20709376;
constexpr size_t SM_MOD = 0  , SM_LB = 2 * 17 * 9216  ;
constexpr size_t AB_Q = 0, AB_K = (size_t)T * 512, AB_VTL = 2 * (size_t)T * 512, AB_VTC = AB_VTL + (size_t)NB * 512 * SEQ, AB_U = AB_VTC + (size_t)NB * 512 * CTXL;
constexpr size_t PLANE = (size_t)T * 1024;

struct Params { const float* in[19]; float* out; unsigned char* ws; int ph_lo, ph_hi; };

__device__ __forceinline__ unsigned pk2(float lo, float hi) { unsigned r; asm("v_cvt_pk_bf16_f32 %0, %1, %2" : "=v"(r) : "v"(lo), "v"(hi)); return r; }
__device__ __forceinline__ bf16_t f2bf(float x) { unsigned u = __float_as_uint(x); u += 0x7fffu + ((u >> 16) & 1u); return (bf16_t)(u >> 16); }
__device__ __forceinline__ float bflo(unsigned v) { return __uint_as_float(v << 16); }
__device__ __forceinline__ float bfhi(unsigned v) { return __uint_as_float(v & 0xffff0000u); }
__device__ __forceinline__ float bf2f(bf16_t v) { return __uint_as_float((unsigned)v << 16); }
__device__ __forceinline__ float silu_f(float a) { return a * __builtin_amdgcn_rcpf(1.0f + __expf(-a)); }
__device__ __forceinline__ bf16x8 mkfrag(unsigned a, unsigned b, unsigned c, unsigned d) { u32x4 w = {a, b, c, d}; return __builtin_bit_cast(bf16x8, w); }
#define MFMA16(a, b, c) __builtin_amdgcn_mfma_f32_16x16x32_bf16((a), (b), (c), 0, 0, 0)

struct EpiSwiGLU {
    static constexpr bool PERM = false, AFTER_DRAIN = false;
    bf16_t* act;
    __device__ __forceinline__ void operator()(const f32x4 (&acc)[2][2][4][2], const pg8::Unit& u, int wr, int wc, int fr, int fq) const {
        const int row0 = u.pm * 256 + wr * 64 + fr;
#pragma unroll
        for (int ai = 0; ai < 2; ++ai)
#pragma unroll
            for (int m = 0; m < 4; ++m) {
                bf16_t* rowp = act + (size_t)(row0 + ai * 128 + m * 16) * DFF + 4 * fq;
#pragma unroll
                for (int bj = 0; bj < 2; ++bj) {
                    const int g32 = 8 * u.pn + 4 * bj + wc;
                    const f32x4 a = acc[ai][bj][m][0], b = acc[ai][bj][m][1];
                    u32x2 w; w.x = pk2(silu_f(a[0]) * b[0], silu_f(a[1]) * b[1]); w.y = pk2(silu_f(a[2]) * b[2], silu_f(a[3]) * b[3]);
                    *(u32x2*)(rowp + 16 * g32) = w;
                }
            }
    }
};
struct EpiRes {
    static constexpr bool PERM = false, AFTER_DRAIN = false;
    const float* base_l; const float* base_c; float* out_l; float* out_c; const float* gate; float coef;
    __device__ __forceinline__ void operator()(const f32x4 (&acc)[2][2][4][2], const pg8::Unit& u, int wr, int wc, int fr, int fq) const {
        const int row0 = u.pm * 256; const bool lat = row0 < NLAT; const int j = lat ? (row0 >> 11) : 16;
        const float* bp = lat ? base_l + (size_t)row0 * D : base_c + (size_t)(row0 - NLAT) * D;
        float* op = lat ? out_l + (size_t)row0 * D : out_c + (size_t)(row0 - NLAT) * D;
        const int col0 = u.pn * 256 + wc * 32 + 4 * fq;
        const float* gp = gate + (size_t)j * NMOD + col0;
        f32x4 gv[2][2];
#pragma unroll
        for (int bj = 0; bj < 2; ++bj)
#pragma unroll
            for (int n = 0; n < 2; ++n) gv[bj][n] = *(const f32x4*)(gp + bj * 128 + n * 16) * coef;
#pragma unroll
        for (int ai = 0; ai < 2; ++ai)
#pragma unroll
            for (int m = 0; m < 4; ++m) {
                const size_t off = (size_t)(wr * 64 + fr + ai * 128 + m * 16) * D + col0;
#pragma unroll
                for (int bj = 0; bj < 2; ++bj)
#pragma unroll
                    for (int n = 0; n < 2; ++n) {
                        const f32x4 bs = *(const f32x4*)(bp + off + bj * 128 + n * 16);
                        *(f32x4*)(op + off + bj * 128 + n * 16) = bs + gv[bj][n] * acc[ai][bj][m][n];
                    }
            }
    }
};
struct EpiAB {
    static constexpr bool PERM = false, AFTER_DRAIN = false;
    bf16_t* big;
    __device__ __forceinline__ void operator()(const f32x4 (&acc)[2][2][4][2], const pg8::Unit& u, int wr, int wc, int fr, int fq) const {
        const int sect = u.pn >> 1; const int row0 = u.pm * 256 + wr * 64 + fr; const int colbase = (u.pn & 1) * 256 + wc * 32 + 4 * fq;
        if (sect != 2) {
            bf16_t* dst = big + (sect == 0 ? AB_Q : (sect == 1 ? AB_K : AB_U)); const float sc = sect == 0 ? 0.125f : 1.0f;
#pragma unroll
            for (int ai = 0; ai < 2; ++ai)
#pragma unroll
                for (int m = 0; m < 4; ++m) {
                    bf16_t* rowp = dst + (size_t)(row0 + ai * 128 + m * 16) * 512 + colbase;
#pragma unroll
                    for (int bj = 0; bj < 2; ++bj)
#pragma unroll
                        for (int n = 0; n < 2; ++n) { const f32x4 v = acc[ai][bj][m][n] * sc; u32x2 w; w.x = pk2(v[0], v[1]); w.y = pk2(v[2], v[3]); *(u32x2*)(rowp + bj * 128 + n * 16) = w; }
                }
        } else {
            const bool lat = u.pm * 256 < NLAT;
#pragma unroll
            for (int ai = 0; ai < 2; ++ai)
#pragma unroll
                for (int m = 0; m < 4; ++m) {
                    const int row = row0 + ai * 128 + m * 16;
                    bf16_t* bp; size_t sd;
                    if (lat) { const int b = row >> 11, tok = row & 2047; bp = big + AB_VTL + ((size_t)b * 512 + colbase) * SEQ + tok; sd = SEQ; }
                    else { const int rc = row - NLAT; const int b = rc >> 8, tok = rc & 255; bp = big + AB_VTC + ((size_t)b * 512 + colbase) * CTXL + tok; sd = CTXL; }
#pragma unroll
                    for (int bj = 0; bj < 2; ++bj)
#pragma unroll
                        for (int n = 0; n < 2; ++n)
#pragma unroll
                            for (int j = 0; j < 4; ++j) bp[(size_t)(bj * 128 + n * 16 + j) * sd] = f2bf(acc[ai][bj][m][n][j]);
                }
        }
    }
};
struct EpiHG {
    static constexpr bool PERM = false, AFTER_DRAIN = false;
    bf16_t* planes;
    __device__ __forceinline__ void operator()(const f32x4 (&acc)[2][2][4][2], const pg8::Unit& u, int wr, int wc, int fr, int fq) const {
        const int plane = u.pn >> 2; const int row0 = u.pm * 256 + wr * 64 + fr; const int colbase = (u.pn & 3) * 256 + wc * 32 + 4 * fq;
        bf16_t* dst = planes + (size_t)plane * PLANE; const bool act = (plane == 0) || (plane == 4);
#pragma unroll
        for (int ai = 0; ai < 2; ++ai)
#pragma unroll
            for (int m = 0; m < 4; ++m) {
                bf16_t* rowp = dst + (size_t)(row0 + ai * 128 + m * 16) * 1024 + colbase;
#pragma unroll
                for (int bj = 0; bj < 2; ++bj)
#pragma unroll
                    for (int n = 0; n < 2; ++n) {
                        f32x4 v = acc[ai][bj][m][n];
                        if (act) { v[0] = silu_f(v[0]); v[1] = silu_f(v[1]); v[2] = silu_f(v[2]); v[3] = silu_f(v[3]); }
                        u32x2 w; w.x = pk2(v[0], v[1]); w.y = pk2(v[2], v[3]); *(u32x2*)(rowp + bj * 128 + n * 16) = w;
                    }
            }
    }
};

template <class Epi> __device__ __forceinline__ void run_gemm(PG8_LAS unsigned char* lds, const bf16_t* A, const bf16_t* Bt, int M, int N, int K, const Epi& E) {
    pg8::Gemm g{A, Bt, M, N, K}; pg8::StaticOrder S; S.init(M, N, (int)gridDim.x, (int)blockIdx.x);
    pg8::gemm_phase<Epi, pg8::StaticOrder, false>(lds, g, S, E, nullptr);
}

struct ConvJob { const float* src; bf16_t* dst; int ld, dstld, K, N, mode; };
__device__ __forceinline__ void conv_tile(unsigned char* lds, const ConvJob jb, int tile) {
    float* tl = (float*)lds;
    const int tid = threadIdx.x; const int ktiles = jb.K >> 6; const int rt = tile / ktiles, kt = tile - rt * ktiles; const int r0 = rt * 64, k0 = kt * 64;
    {
        const int r = tid & 63, kk = tid >> 6; const int rho = r0 + r; int col = rho;
        if (jb.mode == 1) col = ((rho >> 4) & 1) * DFF + 16 * (rho >> 5) + (rho & 15);
        const float* sp = jb.src + (size_t)(k0 + kk) * jb.ld + col;
#pragma unroll
        for (int i = 0; i < 8; ++i) tl[(kk + 8 * i) * 65 + r] = sp[(size_t)(8 * i) * jb.ld];
    }
    __syncthreads();
    {
        const int r = tid >> 3, ks = tid & 7; float v[8];
#pragma unroll
        for (int e = 0; e < 8; ++e) v[e] = tl[(ks * 8 + e) * 65 + r];
        u32x4 w; w.x = pk2(v[0], v[1]); w.y = pk2(v[2], v[3]); w.z = pk2(v[4], v[5]); w.w = pk2(v[6], v[7]);
        *(u32x4*)(jb.dst + (size_t)(r0 + r) * jb.dstld + k0 + ks * 8) = w;
    }
    __syncthreads();
}
__device__ __forceinline__ void prep_weights(unsigned char* lds, const Params& P, int layer) {
    bf16_t* bt = (bf16_t*)(P.ws + WS_BT);
    const float* w13 = P.in[7]; const float* w2 = P.in[8];
    const int b1 = 1408, b2 = 2112, b3 = layer == 0 ? 2624 : 3392, b4 = layer == 0 ? 2752 : 3648, b5 = b4 + 1408, b6 = b5 + 704;
    for (int t = blockIdx.x; t < b6; t += gridDim.x) {
        ConvJob jb; int tile;
        if (t < b1) { jb.src = w13 + (size_t)(layer * 2 + 0) * 1024 * 5632; jb.dst = bt + BT_W13A; jb.ld = 5632; jb.dstld = 1024; jb.K = 1024; jb.N = 5632; jb.mode = 1; tile = t; }
        else if (t < b2) { jb.src = w2 + (size_t)(layer * 2 + 0) * 2816 * 1024; jb.dst = bt + BT_W2A; jb.ld = 1024; jb.dstld = 2816; jb.K = 2816; jb.N = 1024; jb.mode = 0; tile = t - b1; }
        else if (t < b3) {
            if (layer == 0) { jb.src = P.in[9]; jb.ld = 2048; jb.N = 2048; } else { jb.src = P.in[14]; jb.ld = 5120; jb.N = 5120; }
            jb.dst = bt + BT_MIXIN; jb.dstld = 1024; jb.K = 1024; jb.mode = 0; tile = t - b2; }
        else if (t < b4) {
            if (layer == 0) { jb.src = P.in[13]; jb.K = 512; } else { jb.src = P.in[17]; jb.K = 1024; }
            jb.dst = bt + BT_MIXOUT; jb.ld = 1024; jb.dstld = 1024; jb.N = 1024; jb.mode = 0; tile = t - b3; }
        else if (t < b5) { jb.src = w13 + (size_t)(layer * 2 + 1) * 1024 * 5632; jb.dst = bt + BT_W13B; jb.ld = 5632; jb.dstld = 1024; jb.K = 1024; jb.N = 5632; jb.mode = 1; tile = t - b4; }
        else { jb.src = w2 + (size_t)(layer * 2 + 1) * 2816 * 1024; jb.dst = bt + BT_W2B; jb.ld = 1024; jb.dstld = 2816; jb.K = 2816; jb.N = 1024; jb.mode = 0; tile = t - b5; }
        conv_tile(lds, jb, tile);
    }
}
__device__ __forceinline__ void pool_fold(const Params& P) {
    bf16_t* bto = (bf16_t*)(P.ws + WS_BT) + BT_MIXOUT; const float* pw = P.in[11]; const float* ps = P.in[12]; const float* wo = P.in[13];
    for (int item = blockIdx.x; item < 1024; item += gridDim.x) {
        const int kk = item >> 1, n = (item & 1) * 512 + threadIdx.x, g = kk >> 7, c = kk & 127;
        const float* pwr = pw + (size_t)(g * 128 + c) * 128; const float* psr = ps + g * 128; const float* wor = wo + (size_t)(512 + g * 128) * 1024 + n;
        float acc = 0.f;
#pragma unroll 8
        for (int d = 0; d < 128; ++d) acc += pwr[d] * psr[d] * wor[(size_t)d * 1024];
        bto[(size_t)n * 1024 + 512 + kk] = f2bf(acc);
    }
}
__device__ __forceinline__ void mod_phase(unsigned char* lds, const Params& P) {
    float* sc = (float*)lds;
    float* red = sc + 17 * 1024;
    const int tid = threadIdx.x; const float* c = P.in[1]; const float* cc = P.in[3]; const float* wm = P.in[4]; const float* bm = P.in[5];
    float* small = (float*)(P.ws + WS_SMALL);
    for (int i = blockIdx.x * 512 + tid; i < 2048; i += gridDim.x * 512) { const float l0 = P.in[15][i], l1 = P.in[15][2048 + i]; small[SM_LB + i] = 1.0f / (1.0f + __expf(l0 - l1)); }
    for (int idx = tid; idx < 17 * 1024; idx += 512) { const int j = idx >> 10, k = idx & 1023; const float v = j < 16 ? c[j * 1024 + k] : cc[k]; sc[idx] = v / (1.0f + __expf(-v)); }
    __syncthreads();
    for (int item = blockIdx.x; item < 288; item += gridDim.x) {
        const int l = item / 144, nb = item - l * 144; const int cl = tid & 63, kg = tid >> 6; const int col = nb * 64 + cl;
        const float* wp = wm + (size_t)l * 1024 * NMOD + (size_t)(kg * 128) * NMOD + col;
        float acc[17];
#pragma unroll
        for (int j = 0; j < 17; ++j) acc[j] = 0.f;
        for (int k = 0; k < 128; k += 4) {
            const float w0 = wp[(size_t)(k + 0) * NMOD], w1 = wp[(size_t)(k + 1) * NMOD], w2 = wp[(size_t)(k + 2) * NMOD], w3 = wp[(size_t)(k + 3) * NMOD];
#pragma unroll
            for (int j = 0; j < 17; ++j) { const f32x4 s = *(const f32x4*)(sc + j * 1024 + kg * 128 + k); acc[j] += s[0] * w0 + s[1] * w1 + s[2] * w2 + s[3] * w3; }
        }
#pragma unroll
        for (int j = 0; j < 17; ++j) red[(kg * 17 + j) * 64 + cl] = acc[j];
        __syncthreads();
        for (int o = tid; o < 17 * 64; o += 512) {
            const int j = o >> 6, c2 = o & 63; float s = 0.f;
#pragma unroll
            for (int q = 0; q < 8; ++q) s += red[(q * 17 + j) * 64 + c2];
            small[SM_MOD + ((size_t)l * 17 + j) * NMOD + nb * 64 + c2] = s + bm[l * NMOD + nb * 64 + c2];
        }
        __syncthreads();
    }
}

__device__ __forceinline__ float wave_sum(float v) {
#pragma unroll
    for (int o = 32; o >= 1; o >>= 1) v += __shfl_xor(v, o);
    return v;
}
__device__ __forceinline__ void norm_phase(const float* hl, const float* hc, const float* g, const float* modl, int sh_idx, int sc_idx, bf16_t* xn, int nrows) {
    const int lane = threadIdx.x & 63; const int gw = blockIdx.x * 8 + (threadIdx.x >> 6), nw = gridDim.x * 8;
    for (int row = gw; row < nrows; row += nw) {
        const bool lat = row < NLAT; const float* src = lat ? hl + (size_t)row * D : hc + (size_t)(row - NLAT) * D; const int j = lat ? (row >> 11) : 16;
        const float* shp = modl + (size_t)j * NMOD + sh_idx * 1024; const float* scp = modl + (size_t)j * NMOD + sc_idx * 1024;
        f32x4 v[4]; float ss = 0.f;
#pragma unroll
        for (int i = 0; i < 4; ++i) { v[i] = *(const f32x4*)(src + i * 256 + lane * 4); ss += v[i][0] * v[i][0] + v[i][1] * v[i][1] + v[i][2] * v[i][2] + v[i][3] * v[i][3]; }
        ss = wave_sum(ss);
        const float r = rsqrtf(ss * (1.0f / 1024.0f) + EPS);
#pragma unroll
        for (int i = 0; i < 4; ++i) {
            const int cidx = i * 256 + lane * 4;
            const f32x4 gg = *(const f32x4*)(g + cidx), s1 = *(const f32x4*)(scp + cidx), s0 = *(const f32x4*)(shp + cidx);
            const f32x4 y = v[i] * r * gg * (s1 + 1.0f) + s0;
            u32x2 w; w.x = pk2(y[0], y[1]); w.y = pk2(y[2], y[3]); *(u32x2*)(xn + (size_t)row * D + cidx) = w;
        }
    }
}
__device__ __forceinline__ void final_norm_phase(float* h, const float* g) {
    const int lane = threadIdx.x & 63; const int gw = blockIdx.x * 8 + (threadIdx.x >> 6), nw = gridDim.x * 8;
    for (int row = gw; row < NLAT; row += nw) {
        float* src = h + (size_t)row * D; f32x4 v[4]; float ss = 0.f;
#pragma unroll
        for (int i = 0; i < 4; ++i) { v[i] = *(const f32x4*)(src + i * 256 + lane * 4); ss += v[i][0] * v[i][0] + v[i][1] * v[i][1] + v[i][2] * v[i][2] + v[i][3] * v[i][3]; }
        ss = wave_sum(ss);
        const float r = rsqrtf(ss * (1.0f / 1024.0f) + EPS);
#pragma unroll
        for (int i = 0; i < 4; ++i) { const int cidx = i * 256 + lane * 4; const f32x4 gg = *(const f32x4*)(g + cidx); *(f32x4*)(src + cidx) = v[i] * r * gg; }
    }
}
__device__ __forceinline__ void readout_phase(const bf16_t* planes, const float* gnorm, bf16_t* dst) {
    const int lane = threadIdx.x & 63; const int gw = blockIdx.x * 8 + (threadIdx.x >> 6), nw = gridDim.x * 8;
    const int c0 = lane * 16;
    float gn[16];
#pragma unroll
    for (int e = 0; e < 16; ++e) gn[e] = gnorm[(c0 + e) & 127];
    for (int row = gw; row < NLAT; row += nw) {
        const size_t off = (size_t)row * 1024 + c0;
        const u32x4 a0 = *(const u32x4*)(planes + 2 * PLANE + off), a1 = *(const u32x4*)(planes + 2 * PLANE + off + 8);
        const u32x4 b0 = *(const u32x4*)(planes + 3 * PLANE + off), b1 = *(const u32x4*)(planes + 3 * PLANE + off + 8);
        const u32x4 g0 = *(const u32x4*)(planes + 4 * PLANE + off), g1 = *(const u32x4*)(planes + 4 * PLANE + off + 8);
        float o[16], sg[16]; float ss = 0.f;
#pragma unroll
        for (int q = 0; q < 4; ++q) {
            o[2 * q] = bflo(a0[q]) + bflo(b0[q]); o[2 * q + 1] = bfhi(a0[q]) + bfhi(b0[q]);
            o[8 + 2 * q] = bflo(a1[q]) + bflo(b1[q]); o[8 + 2 * q + 1] = bfhi(a1[q]) + bfhi(b1[q]);
            sg[2 * q] = bflo(g0[q]); sg[2 * q + 1] = bfhi(g0[q]); sg[8 + 2 * q] = bflo(g1[q]); sg[8 + 2 * q + 1] = bfhi(g1[q]);
        }
#pragma unroll
        for (int e = 0; e < 16; ++e) ss += o[e] * o[e];
        ss += __shfl_xor(ss, 1); ss += __shfl_xor(ss, 2); ss += __shfl_xor(ss, 4);
        const float r = rsqrtf(ss * (1.0f / 128.0f) + EPS);
        u32x4 w0, w1;
#pragma unroll
        for (int q = 0; q < 4; ++q) {
            w0[q] = pk2(o[2 * q] * r * gn[2 * q] * sg[2 * q], o[2 * q + 1] * r * gn[2 * q + 1] * sg[2 * q + 1]);
            w1[q] = pk2(o[8 + 2 * q] * r * gn[8 + 2 * q] * sg[8 + 2 * q], o[8 + 2 * q + 1] * r * gn[8 + 2 * q + 1] * sg[8 + 2 * q + 1]);
        }
        *(u32x4*)(dst + off) = w0; *(u32x4*)(dst + off + 8) = w1;
    }
}

template <bool LOCAL>
__device__ __forceinline__ void attn_half(const bf16_t* big, const float* rp, const bf16x8 (&qf)[2], int b, int h, int r, int r0, int n, int band0, int lane, float& mx_out, float& sum_out, f32x4 (&o)[4]) {
    const int l15 = lane & 15, g = lane >> 4;
    const bf16_t* Kp = big + AB_K;
    f32x4 s[16];
#pragma unroll
    for (int kt = 0; kt < 16; ++kt) {
        int krow;
        if (LOCAL) krow = b * SEQ + (r0 + (kt >> 1)) * 64 + band0 + 16 * (kt & 1) + l15;
        else krow = NLAT + b * CTXL + 16 * kt + l15;
        const bf16_t* kp = Kp + (size_t)krow * 512 + h * 64 + 8 * g;
        const bf16x8 k0 = *(const bf16x8*)kp, k1 = *(const bf16x8*)(kp + 32);
        f32x4 a = {0.f, 0.f, 0.f, 0.f};
        a = MFMA16(k0, qf[0], a); a = MFMA16(k1, qf[1], a);
        s[kt] = a;
        if ((kt & 3) == 3) __builtin_amdgcn_sched_barrier(0);
    }
    if (LOCAL) {
        const int cq = 16 * n + l15; const int wc0 = min(max(cq - 8, 0), 48);
#pragma unroll
        for (int kt = 0; kt < 16; ++kt) {
            const int rowi = r0 + (kt >> 1) - r + 7;
#pragma unroll
            for (int j = 0; j < 4; ++j) {
                const int kcol = band0 + 16 * (kt & 1) + 4 * g + j;
                const bool ok = (kcol >= wc0) && (kcol < wc0 + 16);
                const int rel = min(max(kcol - cq, -15), 15) + 15;
                const float bias = rp[rowi * 31 + rel];
                s[kt][j] = ok ? s[kt][j] + bias : -1e30f;
            }
        }
    }
    float mx = -1e30f;
#pragma unroll
    for (int kt = 0; kt < 16; ++kt) mx = fmaxf(fmaxf(fmaxf(s[kt][0], s[kt][1]), fmaxf(s[kt][2], s[kt][3])), mx);
    mx = fmaxf(mx, __shfl_xor(mx, 16)); mx = fmaxf(mx, __shfl_xor(mx, 32));
    float sum = 0.f;
#pragma unroll
    for (int kt = 0; kt < 16; ++kt) {
#pragma unroll
        for (int j = 0; j < 4; ++j) { const float p = __expf(s[kt][j] - mx); s[kt][j] = p; sum += p; }
    }
    sum += __shfl_xor(sum, 16); sum += __shfl_xor(sum, 32);
#pragma unroll
    for (int mt = 0; mt < 4; ++mt) o[mt] = (f32x4){0.f, 0.f, 0.f, 0.f};
    const bf16_t* vt = LOCAL ? big + AB_VTL + ((size_t)b * 512 + h * 64 + l15) * SEQ + r0 * 64 + band0 + 4 * g
                             : big + AB_VTC + ((size_t)b * 512 + h * 64 + l15) * CTXL + 4 * g;
#pragma unroll
    for (int i = 0; i < 8; ++i) {
        const bf16x8 pb = mkfrag(pk2(s[2 * i][0], s[2 * i][1]), pk2(s[2 * i][2], s[2 * i][3]), pk2(s[2 * i + 1][0], s[2 * i + 1][1]), pk2(s[2 * i + 1][2], s[2 * i + 1][3]));
#pragma unroll
        for (int mt = 0; mt < 4; ++mt) {
            const bf16_t* vp = LOCAL ? vt + (size_t)(16 * mt) * SEQ + i * 64 : vt + (size_t)(16 * mt) * CTXL + 32 * i;
            const u32x2 lo = *(const u32x2*)vp, hi = *(const u32x2*)(vp + 16);
            o[mt] = MFMA16(mkfrag(lo.x, lo.y, hi.x, hi.y), pb, o[mt]);
        }
        if (i & 1) __builtin_amdgcn_sched_barrier(0);
    }
    mx_out = mx; sum_out = sum;
}
template <bool LOCAL>
__device__ __forceinline__ void attn_tile(const bf16_t* big, bf16_t* cat, const float* rpbs, int b, int h, int r, int n, int lane) {
    const int l15 = lane & 15, g = lane >> 4;
    const bf16_t* Qp = big + AB_Q;
    const int qrow = LOCAL ? (b * SEQ + r * 64 + 16 * n + l15) : (NLAT + b * CTXL + 16 * n + l15);
    const int r0 = LOCAL ? min(max(r - 4, 0), 24) : 0;
    const int band0 = LOCAL ? min(max(16 * n - 8, 0), 32) : 0;
    bf16x8 qf[2];
#pragma unroll
    for (int ks = 0; ks < 2; ++ks) qf[ks] = *(const bf16x8*)(Qp + (size_t)qrow * 512 + h * 64 + 32 * ks + 8 * g);
    float m2, l2; f32x4 o[4];
    attn_half<false>(big, rpbs, qf, b, h, r, r0, n, band0, lane, m2, l2, o);
    float sum = l2;
    if (LOCAL) {
        float m1, l1; f32x4 o1[4];
        attn_half<true>(big, rpbs + h * 465, qf, b, h, r, r0, n, band0, lane, m1, l1, o1);
        const float m = fmaxf(m1, m2); const float a1 = __expf(m1 - m), a2 = __expf(m2 - m);
#pragma unroll
        for (int mt = 0; mt < 4; ++mt) o[mt] = o[mt] * a2 + o1[mt] * a1;
        sum = l2 * a2 + l1 * a1;
    }
    const float inv = 1.0f / sum;
    bf16_t* op = cat + (size_t)qrow * 1024 + h * 64 + 4 * g;
#pragma unroll
    for (int mt = 0; mt < 4; ++mt) { u32x2 w; w.x = pk2(o[mt][0] * inv, o[mt][1] * inv); w.y = pk2(o[mt][2] * inv, o[mt][3] * inv); *(u32x2*)(op + 16 * mt) = w; }
}
__device__ __forceinline__ void mixer_ab_phase(unsigned char* lds, const Params& P) {
    float* rpbs = (float*)lds;
    const bf16_t* big = (const bf16_t*)(P.ws + WS_BIG); bf16_t* cat = (bf16_t*)(P.ws + WS_XN);
    const int tid = threadIdx.x, lane = tid & 63;
    for (int i = tid; i < 8 * 465; i += 512) rpbs[i] = P.in[10][i];
    __syncthreads();
    const int gw = blockIdx.x * 8 + (tid >> 6), nw = gridDim.x * 8;
    for (int t = gw; t < 16384; t += nw) { const int n = t & 3, r = (t >> 2) & 31, h = (t >> 7) & 7, b = t >> 10; attn_tile<true>(big, cat, rpbs, b, h, r, n, lane); }
    for (int t = gw; t < 2048; t += nw) { const int n = t & 15, h = (t >> 4) & 7, b = t >> 7; attn_tile<false>(big, cat, rpbs, b, h, 0, n, lane); }
    const bf16_t* U = big + AB_U;
    for (int idx = blockIdx.x * 512 + tid; idx < T * 64; idx += gridDim.x * 512) {
        const int row = idx >> 6, c8 = idx & 63, ch = c8 * 8, grp = c8 >> 4, w = 2 << grp, half = w >> 1;
        int base, L, t;
        if (row < NLAT) { base = row & ~2047; L = SEQ; t = row & 2047; } else { const int rc = row - NLAT; base = NLAT + (rc & ~255); L = CTXL; t = rc & 255; }
        const int lo = max(t - half, 0), hi = min(t - half + w, L);
        float acc[8];
#pragma unroll
        for (int e = 0; e < 8; ++e) acc[e] = 0.f;
        for (int tt = lo; tt < hi; ++tt) {
            const u32x4 v = *(const u32x4*)(U + (size_t)(base + tt) * 512 + ch);
#pragma unroll
            for (int q = 0; q < 4; ++q) { acc[2 * q] += bflo(v[q]); acc[2 * q + 1] += bfhi(v[q]); }
        }
        const u32x4 sv = *(const u32x4*)(U + (size_t)row * 512 + ch);
        const float invn = 1.0f / (float)(hi - lo);
        u32x4 w4;
#pragma unroll
        for (int q = 0; q < 4; ++q) w4[q] = pk2(acc[2 * q] * invn - bflo(sv[q]), acc[2 * q + 1] * invn - bfhi(sv[q]));
        *(u32x4*)(cat + (size_t)row * 1024 + 512 + ch) = w4;
    }
}

__device__ __forceinline__ void scan_phase(unsigned char* lds, const Params& P) {
    float* Lg = (float*)lds;
    float* Pt = Lg + 32 * 132;
    float* EG = Pt + 512;
    bf16_t* Qh = (bf16_t*)(EG + 128);
    bf16_t* Qt = Qh + 32 * 136;
    bf16_t* Kt = Qt + 32 * 136;
    bf16_t* KhT = Kt + 32 * 136;
    bf16_t* VT = KhT + 128 * 40;
    bf16_t* Am = VT + 128 * 40;
    bf16_t* planes = (bf16_t*)(P.ws + WS_BIG);
    const float* lbv = (const float*)(P.ws + WS_SMALL) + SM_LB;
    const int tid = threadIdx.x, lane = tid & 63, w = tid >> 6, g = lane >> 4, l15 = lane & 15;
    const int p = tid >> 4, c8 = tid & 15;
    for (int chain = blockIdx.x; chain < 256; chain += gridDim.x) {
        const int dir = chain & 1, h = (chain >> 1) & 7, b = chain >> 4;
        const int col = h * 128 + 8 * c8;
        const bf16_t* qpl = planes; const bf16_t* ipl = planes + PLANE; bf16_t* fpl = planes + (size_t)(2 + dir) * PLANE;
        float lb[8], oml[8];
#pragma unroll
        for (int e = 0; e < 8; ++e) { lb[e] = lbv[dir * 1024 + col + e]; oml[e] = 1.0f - lb[e]; }
        f32x4 S[8];
#pragma unroll
        for (int m = 0; m < 8; ++m) S[m] = (f32x4){0.f, 0.f, 0.f, 0.f};
        const int sgn = dir ? -1 : 1;
        u32x4 nf, nv, nq; nq = (u32x4){0u, 0u, 0u, 0u};
        {
            const int r0c = NLAT + b * CTXL + (dir ? CTXL - 1 : 0);
            const size_t off = (size_t)(r0c + sgn * p) * 1024 + col;
            nf = *(const u32x4*)(fpl + off); nv = *(const u32x4*)(ipl + off);
        }
        for (int c = 0; c < 72; ++c) {
            const bool need_o = c >= 8;
            const int r0c = need_o ? (b * SEQ + (dir ? SEQ - 1 - 32 * (c - 8) : 32 * (c - 8))) : (NLAT + b * CTXL + (dir ? CTXL - 1 - 32 * c : 32 * c));
            const u32x4 cf = nf, cv = nv, cq = nq;
            if (c + 1 < 72) {
                const int c1 = c + 1; const bool no1 = c1 >= 8;
                const int r1 = no1 ? (b * SEQ + (dir ? SEQ - 1 - 32 * (c1 - 8) : 32 * (c1 - 8))) : (NLAT + b * CTXL + (dir ? CTXL - 1 - 32 * c1 : 32 * c1));
                const size_t off = (size_t)(r1 + sgn * p) * 1024 + col;
                nf = *(const u32x4*)(fpl + off); nv = *(const u32x4*)(ipl + off);
                if (no1) nq = *(const u32x4*)(qpl + off);
            }
            float kk[8];
            {
                float lg[8];
#pragma unroll
                for (int e = 0; e < 8; ++e) {
                    float x = (e & 1) ? bfhi(cf[e >> 1]) : bflo(cf[e >> 1]);
                    x = fminf(fmaxf(x, -30.f), 30.f);
                    const float ex = __expf(-x); const float sg = __builtin_amdgcn_rcpf(1.0f + ex);
                    const float f = lb[e] + oml[e] * sg;
                    lg[e] = __logf(f); kk[e] = oml[e] * (ex * sg);
                }
                *(f32x4*)(Lg + p * 132 + 8 * c8) = (f32x4){lg[0], lg[1], lg[2], lg[3]};
                *(f32x4*)(Lg + p * 132 + 8 * c8 + 4) = (f32x4){lg[4], lg[5], lg[6], lg[7]};
            }
            __syncthreads();
            {
                const int ch = tid & 127, part = tid >> 7; float loc[8]; float run = 0.f;
#pragma unroll
                for (int i = 0; i < 8; ++i) { run += Lg[(8 * part + i) * 132 + ch]; loc[i] = run; }
                Pt[part * 128 + ch] = run;
                __syncthreads();
                float off = 0.f;
#pragma unroll
                for (int pp = 0; pp < 3; ++pp) if (pp < part) off += Pt[pp * 128 + ch];
#pragma unroll
                for (int i = 0; i < 8; ++i) Lg[(8 * part + i) * 132 + ch] = loc[i] + off;
            }
            __syncthreads();
            {
                const f32x4 G0 = *(const f32x4*)(Lg + p * 132 + 8 * c8), G1 = *(const f32x4*)(Lg + p * 132 + 8 * c8 + 4);
                const f32x4 M0 = *(const f32x4*)(Lg + 15 * 132 + 8 * c8), M1 = *(const f32x4*)(Lg + 15 * 132 + 8 * c8 + 4);
                const f32x4 L0 = *(const f32x4*)(Lg + 31 * 132 + 8 * c8), L1 = *(const f32x4*)(Lg + 31 * 132 + 8 * c8 + 4);
                float qh[8], qt[8], kt[8];
#pragma unroll
                for (int e = 0; e < 8; ++e) {
                    const float G = e < 4 ? G0[e & 3] : G1[e & 3], Gm = e < 4 ? M0[e & 3] : M1[e & 3], Gl = e < 4 ? L0[e & 3] : L1[e & 3];
                    const float kh = kk[e] * __expf(Gl - G);
                    KhT[(8 * c8 + e) * 40 + p] = f2bf(kh);
                    VT[(8 * c8 + e) * 40 + p] = (bf16_t)((e & 1) ? (cv[e >> 1] >> 16) : (cv[e >> 1] & 0xffffu));
                    if (p == 31) EG[8 * c8 + e] = __expf(G);
                    if (need_o) {
                        const float q = (e & 1) ? bfhi(cq[e >> 1]) : bflo(cq[e >> 1]);
                        qh[e] = q * __expf(G); qt[e] = q * __expf(G - Gm); kt[e] = kk[e] * __expf(Gm - G);
                    }
                }
                if (need_o) {
                    *(u32x4*)(Qh + p * 136 + 8 * c8) = (u32x4){pk2(qh[0], qh[1]), pk2(qh[2], qh[3]), pk2(qh[4], qh[5]), pk2(qh[6], qh[7])};
                    *(u32x4*)(Qt + p * 136 + 8 * c8) = (u32x4){pk2(qt[0], qt[1]), pk2(qt[2], qt[3]), pk2(qt[4], qt[5]), pk2(qt[6], qt[7])};
                    *(u32x4*)(Kt + p * 136 + 8 * c8) = (u32x4){pk2(kt[0], kt[1]), pk2(kt[2], kt[3]), pk2(kt[4], kt[5]), pk2(kt[6], kt[7])};
                }
            }
            __syncthreads();
            const bf16x8 bv = *(const bf16x8*)(VT + (16 * w + l15) * 40 + 8 * g);
            if (need_o) {
                f32x4 o[2]; o[0] = (f32x4){0.f, 0.f, 0.f, 0.f}; o[1] = (f32x4){0.f, 0.f, 0.f, 0.f};
#pragma unroll
                for (int ks = 0; ks < 4; ++ks) {
                    const bf16x8 sb = mkfrag(pk2(S[2 * ks][0], S[2 * ks][1]), pk2(S[2 * ks][2], S[2 * ks][3]), pk2(S[2 * ks + 1][0], S[2 * ks + 1][1]), pk2(S[2 * ks + 1][2], S[2 * ks + 1][3]));
#pragma unroll
                    for (int mt = 0; mt < 2; ++mt) {
                        const bf16_t* ap = Qh + (16 * mt + l15) * 136 + 32 * ks + 4 * g;
                        const u32x2 lo = *(const u32x2*)ap, hi = *(const u32x2*)(ap + 16);
                        o[mt] = MFMA16(mkfrag(lo.x, lo.y, hi.x, hi.y), sb, o[mt]);
                    }
                }
                if (w < 4) {
                    const int tm = w >> 1, sn = w & 1; f32x4 a = {0.f, 0.f, 0.f, 0.f};
                    if (!(tm == 0 && sn == 1)) {
#pragma unroll
                        for (int ks = 0; ks < 4; ++ks) {
                            const bf16x8 af = *(const bf16x8*)(Qt + (16 * tm + l15) * 136 + 32 * ks + 8 * g);
                            const bf16x8 bf = *(const bf16x8*)(Kt + (16 * sn + l15) * 136 + 32 * ks + 8 * g);
                            a = MFMA16(af, bf, a);
                        }
                    }
                    const int s_ = 16 * sn + l15;
#pragma unroll
                    for (int j = 0; j < 4; ++j) { const int t_ = 16 * tm + 4 * g + j; Am[t_ * 40 + s_] = f2bf(s_ <= t_ ? a[j] : 0.f); }
                }
                __syncthreads();
#pragma unroll
                for (int mt = 0; mt < 2; ++mt) { const bf16x8 af = *(const bf16x8*)(Am + (16 * mt + l15) * 40 + 8 * g); o[mt] = MFMA16(af, bv, o[mt]); }
#pragma unroll
                for (int mt = 0; mt < 2; ++mt)
#pragma unroll
                    for (int j = 0; j < 4; ++j) { const int t_ = 16 * mt + 4 * g + j; fpl[(size_t)(r0c + sgn * t_) * 1024 + h * 128 + 16 * w + l15] = f2bf(o[mt][j]); }
            }
#pragma unroll
            for (int m = 0; m < 8; ++m) {
                const f32x4 eg = *(const f32x4*)(EG + 16 * m + 4 * g);
                const bf16x8 af = *(const bf16x8*)(KhT + (16 * m + l15) * 40 + 8 * g);
                S[m] = MFMA16(af, bv, S[m] * eg);
            }
        }
        __syncthreads();
    }
}

__global__ void __launch_bounds__(512) mk_fwd(Params P) {
    extern __shared__ __attribute__((aligned(16))) unsigned char lds_raw[];
    cg::grid_group grid = cg::this_grid();
    PG8_LAS unsigned char* ldsg = (PG8_LAS unsigned char*)lds_raw;
    unsigned char* ws = P.ws;
    bf16_t* bt = (bf16_t*)(ws + WS_BT); float* hctx = (float*)(ws + WS_HCTX); bf16_t* xn = (bf16_t*)(ws + WS_XN);
    float* small = (float*)(ws + WS_SMALL); bf16_t* big = (bf16_t*)(ws + WS_BIG);
    const float* x = P.in[0]; const float* ctx = P.in[2]; const float* norm_g = P.in[6]; float* hl = P.out;
    const float* mod0 = small + SM_MOD; const float* mod1 = small + SM_MOD + 17 * NMOD;
#define IN(k) (P.ph_lo <= (k) && (k) < P.ph_hi)
#define SEAM(k) do { if (P.ph_lo <= (k) && (k) + 1 < P.ph_hi) grid.sync(); } while (0)

    if (IN(0)) { prep_weights(lds_raw, P, 0); pool_fold(P); mod_phase(lds_raw, P); } SEAM(0);
    if (IN(1)) norm_phase(x, ctx, norm_g + 0 * 1024, mod0, 0, 1, xn, T); SEAM(1);
    if (IN(2)) { EpiSwiGLU E{big}; run_gemm(ldsg, xn, bt + BT_W13A, T, 2 * DFF, D, E); } SEAM(2);
    if (IN(3)) { EpiRes E{x, ctx, hl, hctx, mod0 + 2 * 1024, 0.5f}; run_gemm(ldsg, big, bt + BT_W2A, T, D, DFF, E); } SEAM(3);
    if (IN(4)) norm_phase(hl, hctx, norm_g + 1 * 1024, mod0, 3, 4, xn, T); SEAM(4);
    if (IN(5)) { EpiAB E{big}; run_gemm(ldsg, xn, bt + BT_MIXIN, T, 2048, D, E); } SEAM(5);
    if (IN(6)) mixer_ab_phase(lds_raw, P); SEAM(6);
    if (IN(7)) { EpiRes E{hl, hctx, hl, hctx, mod0 + 5 * 1024, 1.0f}; run_gemm(ldsg, xn, bt + BT_MIXOUT, T, D, D, E); } SEAM(7);
    if (IN(8)) norm_phase(hl, hctx, norm_g + 2 * 1024, mod0, 6, 7, xn, T); SEAM(8);
    if (IN(9)) { EpiSwiGLU E{big}; run_gemm(ldsg, xn, bt + BT_W13B, T, 2 * DFF, D, E); } SEAM(9);
    if (IN(10)) { EpiRes E{hl, hctx, hl, hctx, mod0 + 8 * 1024, 0.5f}; run_gemm(ldsg, big, bt + BT_W2B, T, D, DFF, E); } SEAM(10);
    if (IN(11)) { prep_weights(lds_raw, P, 1); norm_phase(hl, hctx, norm_g + 3 * 1024, mod1, 0, 1, xn, T); } SEAM(11);
    if (IN(12)) { EpiSwiGLU E{big}; run_gemm(ldsg, xn, bt + BT_W13A, T, 2 * DFF, D, E); } SEAM(12);
    if (IN(13)) { EpiRes E{hl, hctx, hl, hctx, mod1 + 2 * 1024, 0.5f}; run_gemm(ldsg, big, bt + BT_W2A, T, D, DFF, E); } SEAM(13);
    if (IN(14)) norm_phase(hl, hctx, norm_g + 4 * 1024, mod1, 3, 4, xn, T); SEAM(14);
    if (IN(15)) { EpiHG E{big}; run_gemm(ldsg, xn, bt + BT_MIXIN, T, 5120, D, E); } SEAM(15);
    if (IN(16)) scan_phase(lds_raw, P); SEAM(16);
    if (IN(17)) readout_phase(big, P.in[16], xn); SEAM(17);
    if (IN(18)) { EpiRes E{hl, hctx, hl, hctx, mod1 + 5 * 1024, 1.0f}; run_gemm(ldsg, xn, bt + BT_MIXOUT, NLAT, D, D, E); } SEAM(18);
    if (IN(19)) norm_phase(hl, hctx, norm_g + 5 * 1024, mod1, 6, 7, xn, NLAT); SEAM(19);
    if (IN(20)) { EpiSwiGLU E{big}; run_gemm(ldsg, xn, bt + BT_W13B, NLAT, 2 * DFF, D, E); } SEAM(20);
    if (IN(21)) { EpiRes E{hl, hctx, hl, hctx, mod1 + 8 * 1024, 0.5f}; run_gemm(ldsg, big, bt + BT_W2B, NLAT, D, DFF, E); } SEAM(21);
    if (IN(22)) final_norm_phase(hl, P.in[18]);
#undef IN
#undef SEAM
}
}

extern "C" void kernel_launch(void* const* d_in, const int* in_sizes, int n_in, void* d_out, int out_size, void* d_ws, size_t ws_size, hipStream_t stream) {
    static int grid = 0;
    if (grid == 0) {
        if (n_in != 19 || ws_size < mk::WS_END) { fprintf(stderr, "kernel_launch: unexpected n_in %d or ws_size %zu (need %zu)\n", n_in, ws_size, (size_t)mk::WS_END); grid = -1; return; }
        int dev = 0, cus = 0, per_cu = 0;
        hipGetDevice(&dev); hipDeviceGetAttribute(&cus, hipDeviceAttributeMultiprocessorCount, dev);
        if (hipFuncSetAttribute((const void*)mk::mk_fwd, hipFuncAttributeMaxDynamicSharedMemorySize, mk::LDS_BYTES) != hipSuccess) { fprintf(stderr, "kernel_launch: hipFuncSetAttribute failed\n"); grid = -1; return; }
        if (hipOccupancyMaxActiveBlocksPerMultiprocessor(&per_cu, (const void*)mk::mk_fwd, 512, mk::LDS_BYTES) != hipSuccess || per_cu < 1) { per_cu = 1; (void)hipGetLastError(); }
        grid = cus * 1;
        (void)per_cu;
    }
    if (grid < 0) return;
    mk::Params p{};
    for (int i = 0; i < 19; ++i) p.in[i] = (const float*)d_in[i];
    p.out = (float*)d_out; p.ws = (unsigned char*)d_ws;
#if MK_PER_PHASE
    for (int ph = 0; ph < mk::NPHASE; ++ph) {
        p.ph_lo = ph; p.ph_hi = ph + 1; void* args[] = {&p};
        hipError_t e = hipLaunchCooperativeKernel((const void*)mk::mk_fwd, dim3(grid), dim3(512), args, mk::LDS_BYTES, stream);
        if (e != hipSuccess) { fprintf(stderr, "cooperative launch failed: %s\n", hipGetErrorString(e)); break; }
    }
#else
    p.ph_lo = 0; p.ph_hi = mk::NPHASE; void* args[] = {&p};
    hipError_t e = hipLaunchCooperativeKernel((const void*)mk::mk_fwd, dim3(grid), dim3(512), args, mk::LDS_BYTES, stream);
    if (e != hipSuccess) fprintf(stderr, "cooperative launch failed: %s (grid %d)\n", hipGetErrorString(e), grid);
#endif
}
```

```cpp
#include <hip/hip_runtime.h>
#include <hip/hip_cooperative_groups.h>
#include <cstdio>
#include <type_traits>
namespace cg = cooperative_groups;
#define PROBE_MASK 0x0u
#define PROBE_K 4
#define PROBE_EPI 0

#ifndef MK_PER_PHASE
#define MK_PER_PHASE 0
#endif

__device__ __forceinline__ int mk_tid(int mk_wid) { int l; asm volatile("v_mbcnt_lo_u32_b32 %0, -1, 0\n\tv_mbcnt_hi_u32_b32 %0, -1, %0" : "=v"(l)); return mk_wid * 64 + l; }
namespace pg8 {
#define PG8_LAS __attribute__((address_space(3)))
typedef unsigned short bf16_t;
typedef short bf16x8 __attribute__((ext_vector_type(8)));
typedef float f32x4 __attribute__((ext_vector_type(4)));
typedef unsigned u32x4 __attribute__((ext_vector_type(4)));
constexpr int BM = 256, BK = 64, HALF = 128, HTB = HALF * BK * 2  , STAGE_BYTES = 8 * HTB, NXCD = 8, WGM = 4;

__host__ __device__ __forceinline__ int lds_byte(int r, int c) { const int st = (r >> 4) * 2 + (c >> 5), rr = r & 15, cc = c & 31, ob = rr * 64 + cc * 2; return st * 1024 + (ob ^ (((ob >> 9) & 1) << 5)); }
__host__ __device__ __forceinline__ void stage_rc(int b, int& R, int& C) { const int st = b / 1024, sb = b % 1024, swz = sb ^ (((sb >> 9) & 1) << 5); R = (st >> 1) * 16 + swz / 64; C = (st & 1) * 32 + (swz % 64) / 2; }
__host__ __device__ __forceinline__ int perm32(int rho) { const int n = rho >> 4, i = rho & 15; return 8 * (i >> 2) + 4 * n + (i & 3); }

struct Unit { int pm, pn, k0t, ntu, split; };
struct Gemm { const bf16_t* A; const bf16_t* Bt; int M, N, K; };

struct StaticOrder {
    int nM, nN, nwg, G, c;
    __host__ __device__ void init(int M, int N, int G_, int c_) { nM = M / BM; nN = N / BM; nwg = nM * nN; G = G_; c = c_; }
    __host__ __device__ bool next(int i, Unit& u) const {
        const long L = (long)i * G + c; if (L >= nwg) return false;
        int wgid = (int)L; { const int q = nwg / NXCD, r = nwg % NXCD, xcd = wgid % NXCD, off = wgid / NXCD; wgid = (xcd < r ? xcd * (q + 1) : r * (q + 1) + (xcd - r) * q) + off; }
        const int nig = WGM * nN, gid = wgid / nig, fm = gid * WGM, gsz = (nM - fm) < WGM ? (nM - fm) : WGM;
        u.pm = fm + ((wgid % nig) % gsz); u.pn = (wgid % nig) / gsz; u.k0t = 0; u.ntu = 0; u.split = 0; return true;
    }
    __device__ __forceinline__ void a_ready(const Unit&) const {}
    __device__ __forceinline__ void done(const Unit&) const {}
};

template <class Epi, class Sched, bool STAMP = false>
__device__ __forceinline__ void gemm_phase(PG8_LAS unsigned char* lds, const Gemm g, const Sched S, const Epi E, unsigned long long* stamps, const int mk_wid) {
    const int tid = mk_tid(mk_wid), wid = __builtin_amdgcn_readfirstlane(tid >> 6), lane = tid & 63, wr = wid >> 2, wc = wid & 3, fr = lane & 15, fq = lane >> 4;
    const int K = g.K, nt = K / BK;
    int ts_lo = 0, ts_hi = 0, nts = 0; const unsigned long long rt_entry = STAMP ? (unsigned long long)wall_clock64() : 0ull;
#define PG8_STAMP() do { if (STAMP && wid == 0 && nts < 64) { const unsigned long long _c = (unsigned long long)clock64(); \
        ts_lo = (lane == nts) ? (int)(unsigned)_c : ts_lo; ts_hi = (lane == nts) ? (int)(unsigned)(_c >> 32) : ts_hi; ++nts; } } while (0)
    PG8_STAMP();
    unsigned voffA[2], voffB[2];
#pragma unroll
    for (int i = 0; i < 2; ++i) { int R, C; stage_rc(tid * 16 + i * 8192, R, C); const int Rb = Epi::PERM ? ((R & ~31) + perm32(R & 31)) : R;
        voffA[i] = (unsigned)(R * K + C) * 2u; voffB[i] = (unsigned)(Rb * K + C) * 2u; }
    const size_t kstep = (size_t)(BK * 2);
    const size_t hstep = (size_t)HALF * K * 2;
    const size_t tstep = 2 * hstep;
    const unsigned ldsw = (unsigned)wid * 1024u;
    const int aoff = lds_byte(wr * 64 + fr, fq * 8), boff = lds_byte(wc * 32 + fr, fq * 8);
#define PG8_SA(b, h) (((b) * 2 + (h)) * HTB)
#define PG8_SB(b, h) ((4 + (b) * 2 + (h)) * HTB)
#define PG8_STAGE(bufoff, gbase, voff) do { _Pragma("unroll") for (int _i = 0; _i < 2; ++_i) \
        __builtin_amdgcn_global_load_lds((const unsigned*)((const char*)(gbase) + (voff)[_i]), (PG8_LAS unsigned*)(lds + (bufoff) + ldsw + _i * 8192), 16, 0, 0); } while (0)
#define PG8_LDA(dst, b, h) do { _Pragma("unroll") for (int m = 0; m < 4; ++m) _Pragma("unroll") for (int k = 0; k < 2; ++k) dst[m][k] = *(const PG8_LAS bf16x8*)(lds + PG8_SA(b, h) + aoff + m * 2048 + k * 1024); } while (0)
#define PG8_LDB(dst, b, h) do { _Pragma("unroll") for (int n = 0; n < 2; ++n) _Pragma("unroll") for (int k = 0; k < 2; ++k) dst[n][k] = *(const PG8_LAS bf16x8*)(lds + PG8_SB(b, h) + boff + n * 2048 + k * 1024); } while (0)
#define PG8_MMA(ai, bj, At, Bt) do { __builtin_amdgcn_s_setprio(1); _Pragma("unroll") for (int m = 0; m < 4; ++m) _Pragma("unroll") for (int n = 0; n < 2; ++n) _Pragma("unroll") for (int k = 0; k < 2; ++k) \
        acc[ai][bj][m][n] = __builtin_amdgcn_mfma_f32_16x16x32_bf16(Bt[n][k], At[m][k], acc[ai][bj][m][n], 0, 0, 0); __builtin_amdgcn_s_setprio(0); } while (0)
#define PG8_WAIT_V(n) asm volatile("s_waitcnt vmcnt(" #n ")" ::: "memory")
#define PG8_WAIT_L(n) asm volatile("s_waitcnt lgkmcnt(" #n ")" ::: "memory")
#define PG8_BAR __builtin_amdgcn_s_barrier()
#define PG8_SCHED __builtin_amdgcn_sched_barrier(0)
    Unit cur, nxt; int ui = 0;
    if (!S.next(0, cur)) return;
    f32x4 acc[2][2][4][2];
#pragma unroll
    for (int a = 0; a < 2; ++a)
#pragma unroll
        for (int b = 0; b < 2; ++b)
#pragma unroll
            for (int m = 0; m < 4; ++m)
#pragma unroll
                for (int n = 0; n < 2; ++n) acc[a][b][m][n] = (f32x4){0.f, 0.f, 0.f, 0.f};
    bf16x8 At[4][2], B0[2][2], B1[2][2];
    const char* cA = (const char*)g.A + (size_t)cur.pm * tstep + (size_t)cur.k0t * kstep; const char* cB = (const char*)g.Bt + (size_t)cur.pn * tstep + (size_t)cur.k0t * kstep;
    S.a_ready(cur);
    PG8_STAGE(PG8_SB(0, 0), cB, voffB); PG8_STAGE(PG8_SA(0, 0), cA, voffA); PG8_STAGE(PG8_SB(0, 1), cB + hstep, voffB); PG8_STAGE(PG8_SA(0, 1), cA + hstep, voffA);
    if (wr == 1) PG8_BAR;
    PG8_WAIT_V(4); PG8_BAR;
    PG8_STAGE(PG8_SB(1, 0), cB + kstep, voffB); PG8_STAGE(PG8_SA(1, 0), cA + kstep, voffA); PG8_STAGE(PG8_SB(1, 1), cB + hstep + kstep, voffB);
    PG8_WAIT_V(6); PG8_BAR;
    PG8_STAMP();
    for (;;) {
        const bool has_next = S.next(ui + 1, nxt);
        const char* nA = has_next ? (const char*)g.A + (size_t)nxt.pm * tstep + (size_t)nxt.k0t * kstep : cA; const char* nB = has_next ? (const char*)g.Bt + (size_t)nxt.pn * tstep + (size_t)nxt.k0t * kstep : cB;
        const int cnt = cur.ntu ? cur.ntu : nt;
        for (int t = 0; t < cnt; t += 2) {
            const bool last = (t == cnt - 2);
            const char* a1 = cA + (size_t)(t + 1) * kstep;
            const char* a2 = last ? nA : cA + (size_t)(t + 2) * kstep; const char* b2 = last ? nB : cB + (size_t)(t + 2) * kstep;
            const char* a3 = a2 + kstep; const char* b3 = b2 + kstep;
            if (last && has_next) S.a_ready(nxt);
            PG8_LDB(B0, 0, 0); PG8_SCHED; PG8_LDA(At, 0, 0); PG8_STAGE(PG8_SA(1, 1), a1 + hstep, voffA);
            PG8_WAIT_L(8); PG8_BAR; PG8_WAIT_L(0); PG8_MMA(0, 0, At, B0); PG8_BAR; PG8_SCHED;
            PG8_LDB(B1, 0, 1); PG8_STAGE(PG8_SB(0, 0), b2, voffB);
            PG8_BAR; PG8_WAIT_L(0); PG8_MMA(0, 1, At, B1); PG8_BAR;
            PG8_LDA(At, 0, 1); PG8_STAGE(PG8_SA(0, 0), a2, voffA);
            PG8_BAR; PG8_WAIT_L(0); PG8_MMA(1, 0, At, B0); PG8_BAR; PG8_SCHED;
            PG8_STAGE(PG8_SB(0, 1), b2 + hstep, voffB);
            PG8_WAIT_V(6); PG8_BAR; PG8_MMA(1, 1, At, B1); PG8_BAR;
            PG8_LDB(B0, 1, 0); PG8_SCHED; PG8_LDA(At, 1, 0); PG8_STAGE(PG8_SA(0, 1), a2 + hstep, voffA);
            PG8_WAIT_L(8); PG8_BAR; PG8_WAIT_L(0); PG8_MMA(0, 0, At, B0); PG8_BAR; PG8_SCHED;
            PG8_LDB(B1, 1, 1); PG8_STAGE(PG8_SB(1, 0), b3, voffB);
            PG8_BAR; PG8_WAIT_L(0); PG8_MMA(0, 1, At, B1); PG8_BAR;
            PG8_LDA(At, 1, 1); PG8_STAGE(PG8_SA(1, 0), a3, voffA);
            PG8_BAR; PG8_WAIT_L(0); PG8_MMA(1, 0, At, B0); PG8_BAR; PG8_SCHED;
            PG8_STAGE(PG8_SB(1, 1), b3 + hstep, voffB);
            PG8_WAIT_V(6); PG8_BAR; PG8_MMA(1, 1, At, B1); PG8_BAR;
        }
        PG8_STAMP();
        if constexpr (!Epi::AFTER_DRAIN) { E(acc, cur, wr, wc, fr, fq); S.done(cur); }
        PG8_STAMP();
        if (!has_next) break;
#pragma unroll
        for (int a = 0; a < 2; ++a)
#pragma unroll
            for (int b = 0; b < 2; ++b)
#pragma unroll
                for (int m = 0; m < 4; ++m)
#pragma unroll
                    for (int n = 0; n < 2; ++n) acc[a][b][m][n] = (f32x4){0.f, 0.f, 0.f, 0.f};
        cur = nxt; cA = nA; cB = nB; ++ui;
    }
    PG8_WAIT_V(0);
    if (wr == 0) PG8_BAR;
    PG8_BAR;
    if constexpr (Epi::AFTER_DRAIN) { E.fused(acc, cur, wr, wc, fr, fq, lds, wid, lane); S.done(cur); }
    PG8_STAMP();
    if (STAMP && wid == 0) { stamps[lane] = lane < nts ? (((unsigned long long)(unsigned)ts_hi << 32) | (unsigned)ts_lo) : 0ull;
        if (lane == 62) stamps[62] = rt_entry; if (lane == 63) stamps[63] = (unsigned long long)wall_clock64(); }
#undef PG8_STAMP
#undef PG8_SA
#undef PG8_SB
#undef PG8_STAGE
#undef PG8_LDA
#undef PG8_LDB
#undef PG8_MMA
#undef PG8_WAIT_V
#undef PG8_WAIT_L
#undef PG8_BAR
#undef PG8_SCHED
}
}

namespace mk {
using pg8::bf16_t; using pg8::bf16x8; using pg8::f32x4; using pg8::u32x4;
typedef unsigned u32x2 __attribute__((ext_vector_type(2)));

constexpr int D = 1024, NB = 16, SEQ = 2048, CTXL = 256, NLAT = NB * SEQ, NCTX = NB * CTXL, T = NLAT + NCTX, DFF = 2816;
constexpr int NMOD = 9 * 1024;
constexpr float EPS = 1e-6f;
constexpr int LDS_BYTES = 131072 + 1024;
constexpr int NPHASE = 19;

constexpr size_t MiB = (size_t)1 << 20;
constexpr size_t WS_BT = 0, WS_HCTX = 48 * MiB, WS_XN = 64 * MiB, WS_SMALL = 136 * MiB, WS_BIG = 144 * MiB, WS_END = 504 * MiB;
constexpr size_t BT_W13A = 0, BT_W2A = 5767168, BT_MIXIN = 8650752, BT_MIXOUT = 13893632, BT_W13B = 14942208, BT_W2B = 20709376;
constexpr size_t SM_MOD = 0  , SM_LB = 2 * 17 * 9216  ;
constexpr size_t SM_GAM = SM_LB + 2048;
constexpr size_t SM_BIAS_UPA = SM_GAM + 6 * 17 * 1024;
constexpr size_t SM_BIAS_MIX = SM_BIAS_UPA + 17 * 5632;
constexpr size_t SM_BIAS_UPB = SM_BIAS_MIX + 17 * 5120;
constexpr size_t SM_RSS = SM_BIAS_UPB + 17 * 5632;
constexpr size_t WS_XN2 = WS_BIG + 200 * MiB;
constexpr size_t WS_BAR = WS_SMALL + 7 * MiB;
constexpr size_t AB_Q = 0, AB_K = (size_t)T * 512, AB_VTL = 2 * (size_t)T * 512, AB_VTC = AB_VTL + (size_t)NB * 512 * SEQ, AB_U = AB_VTC + (size_t)NB * 512 * CTXL;
constexpr size_t PLANE = (size_t)T * 1024;

struct Params { const float* in[19]; float* out; unsigned char* ws; int ph_lo, ph_hi; };

__device__ __forceinline__ unsigned pk2(float lo, float hi) { unsigned r; asm("v_cvt_pk_bf16_f32 %0, %1, %2" : "=v"(r) : "v"(lo), "v"(hi)); return r; }
__device__ __forceinline__ bf16_t f2bf(float x) { unsigned u = __float_as_uint(x); u += 0x7fffu + ((u >> 16) & 1u); return (bf16_t)(u >> 16); }
__device__ __forceinline__ float bflo(unsigned v) { return __uint_as_float(v << 16); }
__device__ __forceinline__ float bfhi(unsigned v) { return __uint_as_float(v & 0xffff0000u); }
__device__ __forceinline__ float bf2f(bf16_t v) { return __uint_as_float((unsigned)v << 16); }
__device__ __forceinline__ float silu_f(float a) { return a * __builtin_amdgcn_rcpf(1.0f + __expf(-a)); }
__device__ __forceinline__ bf16x8 mkfrag(unsigned a, unsigned b, unsigned c, unsigned d) { u32x4 w = {a, b, c, d}; return __builtin_bit_cast(bf16x8, w); }
#define MFMA16(a, b, c) __builtin_amdgcn_mfma_f32_16x16x32_bf16((a), (b), (c), 0, 0, 0)

struct NormFix { const float* rss; const float* bias; int N; };
__device__ __forceinline__ void load_rowscale(const NormFix& nf, const pg8::Unit& u, int wr, int fr, int fq, float (&r)[2][4]) {
#pragma unroll
    for (int ai = 0; ai < 2; ++ai)
#pragma unroll
        for (int m = 0; m < 4; ++m) {
            const int row = u.pm * 256 + ai * 128 + wr * 64 + m * 16 + fr;
            const f32x4 p = *(const f32x4*)(nf.rss + (size_t)row * 16 + 4 * fq);
            float s = (p[0] + p[1]) + (p[2] + p[3]);
            s += __shfl_xor(s, 16); s += __shfl_xor(s, 32);
            r[ai][m] = rsqrtf(s * (1.0f / 1024.0f) + EPS);
        }
}
__device__ __forceinline__ void load_bias(const NormFix& nf, const pg8::Unit& u, int wc, int fq, f32x4 (&bv)[2][2]) {
    const int row0 = u.pm * 256; const int j = row0 < NLAT ? (row0 >> 11) : 16;
    const float* bp = nf.bias + (size_t)j * nf.N + u.pn * 256 + wc * 32 + 4 * fq;
#pragma unroll
    for (int bj = 0; bj < 2; ++bj)
#pragma unroll
        for (int n = 0; n < 2; ++n) bv[bj][n] = *(const f32x4*)(bp + bj * 128 + n * 16);
}
struct EpiSwiGLU {
    static constexpr bool PERM = false, AFTER_DRAIN = false;
    bf16_t* act; NormFix nf;
    __device__ __forceinline__ void operator()(const f32x4 (&acc)[2][2][4][2], const pg8::Unit& u, int wr, int wc, int fr, int fq) const {
        const int row0 = u.pm * 256 + wr * 64 + fr;
        float r[2][4]; f32x4 bv[2][2]; load_rowscale(nf, u, wr, fr, fq, r); load_bias(nf, u, wc, fq, bv);
#pragma unroll
        for (int ai = 0; ai < 2; ++ai)
#pragma unroll
            for (int m = 0; m < 4; ++m) {
                bf16_t* rowp = act + (size_t)(row0 + ai * 128 + m * 16) * DFF + 4 * fq;
#pragma unroll
                for (int bj = 0; bj < 2; ++bj) {
                    const int g32 = 8 * u.pn + 4 * bj + wc;
                    const f32x4 a = acc[ai][bj][m][0] * r[ai][m] + bv[bj][0], b = acc[ai][bj][m][1] * r[ai][m] + bv[bj][1];
                    u32x2 w; w.x = pk2(silu_f(a[0]) * b[0], silu_f(a[1]) * b[1]); w.y = pk2(silu_f(a[2]) * b[2], silu_f(a[3]) * b[3]);
                    *(u32x2*)(rowp + 16 * g32) = w;
                }
            }
    }
};
template <bool EMIT>
struct EpiRes {
    static constexpr bool PERM = false, AFTER_DRAIN = false;
    const float* base_l; const float* base_c; float* out_l; float* out_c; const float* gate;
    const float* gam; bf16_t* xo; float* rss; float* parts; float coef; int wid;
    __device__ __forceinline__ void operator()(const f32x4 (&acc)[2][2][4][2], const pg8::Unit& u, int wr, int wc, int fr_, int fq_) const {
        const int lane_ = mk_tid(wid) & 63; const int fr = lane_ & 15, fq = lane_ >> 4;
        const int row0 = u.pm * 256; const bool lat = row0 < NLAT; const int j = lat ? (row0 >> 11) : 16;
        const float* bp = lat ? base_l + (size_t)row0 * D : base_c + (size_t)(row0 - NLAT) * D;
        float* op = lat ? out_l + (size_t)row0 * D : out_c + (size_t)(row0 - NLAT) * D;
        const int col0 = u.pn * 256 + wc * 32 + 4 * fq;
        const float* gp = gate + (size_t)j * NMOD + col0;
        if (u.split) {
            float* pp = parts + ((size_t)(u.split - 1) * NCTX + (size_t)(row0 - NLAT)) * D;
#pragma unroll
            for (int bj = 0; bj < 2; ++bj)
#pragma unroll
                for (int n = 0; n < 2; ++n) {
                    const f32x4 gq = *(const f32x4*)(gp + bj * 128 + n * 16) * coef;
#pragma unroll
                    for (int gi = 0; gi < 8; ++gi)
                        *(f32x4*)(pp + (size_t)(wr * 64 + fr + (gi >> 2) * 128 + (gi & 3) * 16) * D + col0 + bj * 128 + n * 16) = gq * acc[gi >> 2][bj][gi & 3][n];
                }
            return;
        }
        f32x4 gv[2][2], gm[2][2];
#pragma unroll
        for (int bj = 0; bj < 2; ++bj)
#pragma unroll
            for (int n = 0; n < 2; ++n) {
                gv[bj][n] = *(const f32x4*)(gp + bj * 128 + n * 16) * coef;
                if (EMIT) gm[bj][n] = *(const f32x4*)(gam + (size_t)j * 1024 + col0 + bj * 128 + n * 16);
            }
        f32x4 bs[2][2], bn[2][2];
        {
            const size_t off = (size_t)(wr * 64 + fr) * D + col0;
#pragma unroll
            for (int bj = 0; bj < 2; ++bj)
#pragma unroll
                for (int n = 0; n < 2; ++n) bn[bj][n] = *(const f32x4*)(bp + off + bj * 128 + n * 16);
        }
#pragma unroll
        for (int gi = 0; gi < 8; ++gi) {
            const int ai = gi >> 2, m = gi & 3;
            const int rl = wr * 64 + fr + ai * 128 + m * 16;
            const size_t off = (size_t)rl * D + col0;
#pragma unroll
            for (int bj = 0; bj < 2; ++bj)
#pragma unroll
                for (int n = 0; n < 2; ++n) bs[bj][n] = bn[bj][n];
            if (gi + 1 < 8) {
                const int rl2 = wr * 64 + fr + ((gi + 1) >> 2) * 128 + ((gi + 1) & 3) * 16;
                const size_t off2 = (size_t)rl2 * D + col0;
#pragma unroll
                for (int bj = 0; bj < 2; ++bj)
#pragma unroll
                    for (int n = 0; n < 2; ++n) bn[bj][n] = *(const f32x4*)(bp + off2 + bj * 128 + n * 16);
            }
            float ssq = 0.f;
#pragma unroll
            for (int bj = 0; bj < 2; ++bj)
#pragma unroll
                for (int n = 0; n < 2; ++n) {
                    const f32x4 hv = bs[bj][n] + gv[bj][n] * acc[ai][bj][m][n];
                    *(f32x4*)(op + off + bj * 128 + n * 16) = hv;
                    if (EMIT) {
                        ssq += (hv[0] * hv[0] + hv[1] * hv[1]) + (hv[2] * hv[2] + hv[3] * hv[3]);
                        const f32x4 a = hv * gm[bj][n];
                        u32x2 w; w.x = pk2(a[0], a[1]); w.y = pk2(a[2], a[3]);
                        *(u32x2*)(xo + (size_t)(row0 + rl) * D + col0 + bj * 128 + n * 16) = w;
                    }
                }
            if (EMIT) {
                ssq += __shfl_xor(ssq, 16); ssq += __shfl_xor(ssq, 32);
                if (fq == 0) rss[(size_t)(row0 + rl) * 16 + u.pn * 4 + wc] = ssq;
            }
        }
    }
};
struct EpiAB {
    static constexpr bool PERM = false, AFTER_DRAIN = false;
    bf16_t* big; NormFix nf;
    __device__ __forceinline__ void operator()(const f32x4 (&acc)[2][2][4][2], const pg8::Unit& u, int wr, int wc, int fr, int fq) const {
        const int sect = u.pn >> 1; const int row0 = u.pm * 256 + wr * 64 + fr; const int colbase = (u.pn & 1) * 256 + wc * 32 + 4 * fq;
        float r[2][4]; f32x4 bv[2][2]; load_rowscale(nf, u, wr, fr, fq, r); load_bias(nf, u, wc, fq, bv);
        if (sect != 2) {
            bf16_t* dst = big + (sect == 0 ? AB_Q : (sect == 1 ? AB_K : AB_U)); const float sc = sect == 0 ? 0.125f : 1.0f;
#pragma unroll
            for (int ai = 0; ai < 2; ++ai)
#pragma unroll
                for (int m = 0; m < 4; ++m) {
                    bf16_t* rowp = dst + (size_t)(row0 + ai * 128 + m * 16) * 512 + colbase;
#pragma unroll
                    for (int bj = 0; bj < 2; ++bj)
#pragma unroll
                        for (int n = 0; n < 2; ++n) { const f32x4 v = (acc[ai][bj][m][n] * r[ai][m] + bv[bj][n]) * sc; u32x2 w; w.x = pk2(v[0], v[1]); w.y = pk2(v[2], v[3]); *(u32x2*)(rowp + bj * 128 + n * 16) = w; }
                }
        } else {
            const bool lat = u.pm * 256 < NLAT;
#pragma unroll
            for (int ai = 0; ai < 2; ++ai)
#pragma unroll
                for (int m = 0; m < 4; ++m) {
                    const int row = row0 + ai * 128 + m * 16;
                    bf16_t* bp; size_t sd;
                    if (lat) { const int b = row >> 11, tok = row & 2047; bp = big + AB_VTL + ((size_t)b * 512 + colbase) * SEQ + tok; sd = SEQ; }
                    else { const int rc = row - NLAT; const int b = rc >> 8, tok = rc & 255; bp = big + AB_VTC + ((size_t)b * 512 + colbase) * CTXL + tok; sd = CTXL; }
#pragma unroll
                    for (int bj = 0; bj < 2; ++bj)
#pragma unroll
                        for (int n = 0; n < 2; ++n)
#pragma unroll
                            for (int j = 0; j < 4; ++j) bp[(size_t)(bj * 128 + n * 16 + j) * sd] = f2bf(acc[ai][bj][m][n][j] * r[ai][m] + bv[bj][n][j]);
                }
        }
    }
};
struct EpiHG {
    static constexpr bool PERM = false, AFTER_DRAIN = false;
    bf16_t* planes; NormFix nf; const float* lbv;
    __device__ __forceinline__ void operator()(const f32x4 (&acc)[2][2][4][2], const pg8::Unit& u, int wr, int wc, int fr, int fq) const {
        float r[2][4]; f32x4 bv[2][2]; load_rowscale(nf, u, wr, fr, fq, r); load_bias(nf, u, wc, fq, bv);
        const int plane = u.pn >> 2;
        const bool gate = (plane == 2) || (plane == 3);
        f32x4 oml[2][2];
        if (gate) {
#pragma unroll
            for (int bj = 0; bj < 2; ++bj)
#pragma unroll
                for (int n = 0; n < 2; ++n) oml[bj][n] = 1.0f - *(const f32x4*)(lbv + (plane - 2) * 1024 + (u.pn & 3) * 256 + wc * 32 + 4 * fq + bj * 128 + n * 16);
        } const int row0 = u.pm * 256 + wr * 64 + fr; const int colbase = (u.pn & 3) * 256 + wc * 32 + 4 * fq;
        bf16_t* dst = planes + (size_t)plane * PLANE; const bool act = (plane == 0) || (plane == 4);
#pragma unroll
        for (int ai = 0; ai < 2; ++ai)
#pragma unroll
            for (int m = 0; m < 4; ++m) {
                bf16_t* rowp = dst + (size_t)(row0 + ai * 128 + m * 16) * 1024 + colbase;
#pragma unroll
                for (int bj = 0; bj < 2; ++bj)
#pragma unroll
                    for (int n = 0; n < 2; ++n) {
                        f32x4 v = acc[ai][bj][m][n] * r[ai][m] + bv[bj][n];
                        if (act) { v[0] = silu_f(v[0]); v[1] = silu_f(v[1]); v[2] = silu_f(v[2]); v[3] = silu_f(v[3]); }
                        if (gate) {
#pragma unroll
                            for (int e = 0; e < 4; ++e) v[e] = oml[bj][n][e] * __builtin_amdgcn_rcpf(1.0f + __expf(fminf(fmaxf(v[e], -30.f), 30.f)));
                        }
                        u32x2 w; w.x = pk2(v[0], v[1]); w.y = pk2(v[2], v[3]); *(u32x2*)(rowp + bj * 128 + n * 16) = w;
                    }
            }
    }
};

struct PrefOrder : pg8::StaticOrder {
    const float* base_l; const float* base_c; PG8_LAS unsigned* sink; int wid;
    __device__ __forceinline__ void a_ready(const pg8::Unit& u) const {
        const int tid = mk_tid(wid);
        const int row0 = u.pm * 256; const float* bp = row0 < NLAT ? base_l + (size_t)row0 * D : base_c + (size_t)(row0 - NLAT) * D;
        bp += u.pn * 256;
#pragma unroll
        for (int i = 0; i < 4; ++i) { const int id = tid + 512 * i; __builtin_amdgcn_global_load_lds((const unsigned*)(bp + (size_t)(id >> 3) * D + (id & 7) * 32), sink, 4, 0, 0); }
    }
};
template <class Epi> __device__ __forceinline__ void run_gemm_res(PG8_LAS unsigned char* lds, const bf16_t* A, const bf16_t* Bt, int M, int N, int K, const Epi E, const int mk_wid) {
    pg8::Gemm g{A, Bt, M, N, K}; PrefOrder S; S.init(M, N, (int)gridDim.x, (int)blockIdx.x);
    S.base_l = E.base_l; S.base_c = E.base_c; S.sink = (PG8_LAS unsigned*)(lds + 131072); S.wid = mk_wid;
    pg8::gemm_phase<Epi, PrefOrder, false>(lds, g, S, E, nullptr, mk_wid);
}
struct SplitOrder {
    pg8::StaticOrder lat; int G, c, ntf;
    __device__ __forceinline__ void init(int N, int K, int G_, int c_) { lat.init(NLAT, N, G_, c_); G = G_; c = c_; ntf = K / 64; }
    __device__ __forceinline__ bool next(int i, pg8::Unit& u) const {
        const long L = (long)i * G + c;
        int pm = 0, pn = 0, k0t = 0, ntu = 0, split = 0; bool ok = true;
        if (L < lat.nwg) { pg8::Unit t; ok = lat.next(i, t); pm = t.pm; pn = t.pn; }
        else {
            const int idx = (int)(L - lat.nwg); ok = idx < 64 * 4;
            const int tile = idx >> 2, part = idx & 3;
            pm = 128 + (tile >> 2); pn = tile & 3; split = 1 + part;
            const int q = ntf >> 2, odd = q & 1, po = part & 1;
            k0t = q * part + (odd & po); ntu = q + odd * (1 - 2 * po);
        }
        u.pm = pm; u.pn = pn; u.k0t = k0t; u.ntu = ntu; u.split = split;
        return ok;
    }
    __device__ __forceinline__ void a_ready(const pg8::Unit&) const {}
    __device__ __forceinline__ void done(const pg8::Unit&) const {}
};
template <class Epi> __device__ __forceinline__ void run_gemm_split(PG8_LAS unsigned char* lds, const bf16_t* A, const bf16_t* Bt, int N, int K, const Epi E, const int mk_wid) {
    pg8::Gemm g{A, Bt, T, N, K}; SplitOrder S; S.init(N, K, (int)gridDim.x, (int)blockIdx.x);
    pg8::gemm_phase<Epi, SplitOrder, false>(lds, g, S, E, nullptr, mk_wid);
}
struct HgOrder {
    pg8::StaticOrder lat; int G, c;
    __device__ __forceinline__ void init(int G_, int c_) { lat.init(NLAT, 5120, G_, c_); G = G_; c = c_; }
    __device__ __forceinline__ bool next(int i, pg8::Unit& u) const {
        const long L = (long)i * G + c;
        int pm = 0, pn = 0; bool ok = true;
        if (L < lat.nwg) { pg8::Unit t; ok = lat.next(i, t); pm = t.pm; pn = t.pn; }
        else { const int idx = (int)(L - lat.nwg); ok = idx < 16 * 12; pm = 128 + idx / 12; pn = 4 + idx % 12; }
        u.pm = pm; u.pn = pn; u.k0t = 0; u.ntu = 0; u.split = 0;
        return ok;
    }
    __device__ __forceinline__ void a_ready(const pg8::Unit&) const {}
    __device__ __forceinline__ void done(const pg8::Unit&) const {}
};
template <class Epi> __device__ __forceinline__ void run_gemm_hg(PG8_LAS unsigned char* lds, const bf16_t* A, const bf16_t* Bt, const Epi E, const int mk_wid) {
    pg8::Gemm g{A, Bt, T, 5120, D}; HgOrder S; S.init((int)gridDim.x, (int)blockIdx.x);
    pg8::gemm_phase<Epi, HgOrder, false>(lds, g, S, E, nullptr, mk_wid);
}
template <class Epi> __device__ __forceinline__ void run_gemm(PG8_LAS unsigned char* lds, const bf16_t* A, const bf16_t* Bt, int M, int N, int K, const Epi E, const int mk_wid) {
    pg8::Gemm g{A, Bt, M, N, K}; pg8::StaticOrder S; S.init(M, N, (int)gridDim.x, (int)blockIdx.x);
    pg8::gemm_phase<Epi, pg8::StaticOrder, false>(lds, g, S, E, nullptr, mk_wid);
}

struct ConvJob { const float* src; bf16_t* dst; int ld, dstld, K, N, mode; };
__device__ __forceinline__ void conv_tile(unsigned char* lds, const ConvJob jb, int tile, const int mk_wid) {
    float* tl = (float*)lds;
    const int tid = mk_tid(mk_wid); const int ktiles = jb.K >> 8; const int rt = tile / ktiles, kt = tile - rt * ktiles; const int r0 = rt * 64, k0 = kt * 256;
    {
        const int r = tid & 63, kk = tid >> 6; const int rho = r0 + r; int col = rho;
        if (jb.mode == 1) col = ((rho >> 4) & 1) * DFF + 16 * (rho >> 5) + (rho & 15);
        const float* sp = jb.src + (size_t)(k0 + kk) * jb.ld + col;
        float v[32];
#pragma unroll
        for (int i = 0; i < 32; ++i) { v[i] = *sp; sp += (size_t)8 * jb.ld; }
#pragma unroll
        for (int i = 0; i < 32; ++i) tl[(kk + 8 * i) * 65 + r] = v[i];
    }
    __syncthreads();
#pragma unroll
    for (int i = 0; i < 4; ++i) {
        const int q = tid + 512 * i; const int r = ((q >> 6) & 7) * 8 + (q & 7), ks = (q >> 9) * 8 + ((q >> 3) & 7); float v[8];
#pragma unroll
        for (int e = 0; e < 8; ++e) v[e] = tl[(ks * 8 + e) * 65 + r];
        u32x4 w; w.x = pk2(v[0], v[1]); w.y = pk2(v[2], v[3]); w.z = pk2(v[4], v[5]); w.w = pk2(v[6], v[7]);
        *(u32x4*)(jb.dst + (size_t)(r0 + r) * jb.dstld + k0 + ks * 8) = w;
    }
    __syncthreads();
}
__device__ __forceinline__ void prep_weights(unsigned char* lds, const Params& P, int layer, const int mk_wid, int t_lo = 0, int t_hi = 1 << 30, int wg0 = 0) {
    bf16_t* bt = (bf16_t*)(P.ws + WS_BT);
    const float* w13 = P.in[7]; const float* w2 = P.in[8];
    const int b1 = 352, b2 = 528, b3 = layer == 0 ? 656 : 848, b4 = layer == 0 ? 688 : 912, b5 = b4 + 352, b6 = b5 + 176;
    if ((int)blockIdx.x < wg0) return;
    const int t_end = t_hi < b6 ? t_hi : b6;
    for (int t = t_lo + (int)blockIdx.x - wg0; t < t_end; t += (int)gridDim.x - wg0) {
        ConvJob jb; int tile;
        if (t < b1) { jb.src = w13 + (size_t)(layer * 2 + 0) * 1024 * 5632; jb.dst = bt + BT_W13A; jb.ld = 5632; jb.dstld = 1024; jb.K = 1024; jb.N = 5632; jb.mode = 1; tile = t; }
        else if (t < b2) { jb.src = w2 + (size_t)(layer * 2 + 0) * 2816 * 1024; jb.dst = bt + BT_W2A; jb.ld = 1024; jb.dstld = 2816; jb.K = 2816; jb.N = 1024; jb.mode = 0; tile = t - b1; }
        else if (t < b3) {
            if (layer == 0) { jb.src = P.in[9]; jb.ld = 2048; jb.N = 2048; } else { jb.src = P.in[14]; jb.ld = 5120; jb.N = 5120; }
            jb.dst = bt + BT_MIXIN; jb.dstld = 1024; jb.K = 1024; jb.mode = 0; tile = t - b2; }
        else if (t < b4) {
            if (layer == 0) { jb.src = P.in[13]; jb.K = 512; } else { jb.src = P.in[17]; jb.K = 1024; }
            jb.dst = bt + BT_MIXOUT; jb.ld = 1024; jb.dstld = 1024; jb.N = 1024; jb.mode = 0; tile = t - b3; }
        else if (t < b5) { jb.src = w13 + (size_t)(layer * 2 + 1) * 1024 * 5632; jb.dst = bt + BT_W13B; jb.ld = 5632; jb.dstld = 1024; jb.K = 1024; jb.N = 5632; jb.mode = 1; tile = t - b4; }
        else { jb.src = w2 + (size_t)(layer * 2 + 1) * 2816 * 1024; jb.dst = bt + BT_W2B; jb.ld = 1024; jb.dstld = 2816; jb.K = 2816; jb.N = 1024; jb.mode = 0; tile = t - b5; }
        conv_tile(lds, jb, tile, mk_wid);
    }
}
__device__ __forceinline__ void pool_fold(unsigned char* lds, const Params& P, const int mk_wid) {
    float* As = (float*)lds;
    float* Bs = As + 128 * 132;
    bf16_t* bto = (bf16_t*)(P.ws + WS_BT) + BT_MIXOUT; const float* pw = P.in[11]; const float* ps = P.in[12]; const float* wo = P.in[13];
    const int tid = mk_tid(mk_wid);
    for (int item = blockIdx.x; item < 64; item += gridDim.x) {
        const int g = item >> 4, nb = item & 15;
        __syncthreads();
#pragma unroll
        for (int i = 0; i < 8; ++i) { const int idx = tid + 512 * i; const int c = idx >> 5, d4 = (idx & 31) * 4;
            const f32x4 a = *(const f32x4*)(pw + (size_t)(g * 128 + c) * 128 + d4), s = *(const f32x4*)(ps + g * 128 + d4); *(f32x4*)(As + c * 132 + d4) = a * s; }
#pragma unroll
        for (int i = 0; i < 4; ++i) { const int idx = tid + 512 * i; const int d = idx >> 4, n4 = (idx & 15) * 4;
            *(f32x4*)(Bs + d * 64 + n4) = *(const f32x4*)(wo + (size_t)(512 + g * 128 + d) * 1024 + nb * 64 + n4); }
        __syncthreads();
        const int n = tid & 63, cg = tid >> 6; float acc[16];
#pragma unroll
        for (int i = 0; i < 16; ++i) acc[i] = 0.f;
#pragma unroll 2
        for (int d = 0; d < 128; d += 4) {
            const float b0 = Bs[(d + 0) * 64 + n], b1 = Bs[(d + 1) * 64 + n], b2 = Bs[(d + 2) * 64 + n], b3 = Bs[(d + 3) * 64 + n];
#pragma unroll
            for (int i = 0; i < 16; ++i) { const f32x4 a = *(const f32x4*)(As + (cg * 16 + i) * 132 + d); acc[i] += a[0] * b0 + a[1] * b1 + a[2] * b2 + a[3] * b3; }
        }
        u32x4 w0, w1;
#pragma unroll
        for (int q = 0; q < 4; ++q) { w0[q] = pk2(acc[2 * q], acc[2 * q + 1]); w1[q] = pk2(acc[8 + 2 * q], acc[8 + 2 * q + 1]); }
        bf16_t* dp = bto + (size_t)(nb * 64 + n) * 1024 + 512 + g * 128 + cg * 16;
        *(u32x4*)dp = w0; *(u32x4*)(dp + 8) = w1;
    }
    __syncthreads();
}
__device__ __forceinline__ void gemv17_item(const float* sc, float* red, const float* wcol4  , size_t ld, float* outp  , size_t outld, const float* badd  , const int mk_wid) {
    const int tid = mk_tid(mk_wid), cl4 = tid & 15, kg = tid >> 4, wv = tid >> 6;
    const float* wp = wcol4 + (size_t)(kg * 32) * ld;
    f32x4 acc[17];
#pragma unroll
    for (int j = 0; j < 17; ++j) acc[j] = (f32x4){0.f, 0.f, 0.f, 0.f};
#pragma unroll 1
    for (int k = 0; k < 32; k += 8) {
        f32x4 w[8];
#pragma unroll
        for (int i = 0; i < 8; ++i) { w[i] = *(const f32x4*)wp; wp += ld; }
#pragma unroll
        for (int q = 0; q < 2; ++q) {
#pragma unroll
            for (int j = 0; j < 17; ++j) { const f32x4 s = *(const f32x4*)(sc + j * 1024 + kg * 32 + k + 4 * q); acc[j] += w[4 * q] * s[0] + w[4 * q + 1] * s[1] + w[4 * q + 2] * s[2] + w[4 * q + 3] * s[3]; }
            __builtin_amdgcn_sched_barrier(0);
        }
    }
#pragma unroll
    for (int j = 0; j < 17; ++j) {
#pragma unroll
        for (int e = 0; e < 4; ++e) { float v = acc[j][e]; v += __shfl_xor(v, 16); v += __shfl_xor(v, 32); acc[j][e] = v; }
        if ((tid & 63) < 16) *(f32x4*)(red + (wv * 17 + j) * 64 + 4 * cl4) = acc[j];
    }
    __syncthreads();
    for (int o = tid; o < 17 * 64; o += 512) {
        const int j = o >> 6, c2 = o & 63; float s = 0.f;
#pragma unroll
        for (int q = 0; q < 8; ++q) s += red[(q * 17 + j) * 64 + c2];
        outp[(size_t)j * outld + c2] = s + (badd ? badd[c2] : 0.f);
    }
    __syncthreads();
}
__device__ __forceinline__ void mod_phase(unsigned char* lds, const Params& P, const int mk_wid) {
    float* sc = (float*)lds;
    float* red = sc + 17 * 1024;
    const int tid = mk_tid(mk_wid); const float* c = P.in[1]; const float* cc = P.in[3]; const float* wm = P.in[4]; const float* bm = P.in[5];
    float* small = (float*)(P.ws + WS_SMALL);
    for (int i = blockIdx.x * 512 + tid; i < 2048; i += gridDim.x * 512) { const float l0 = P.in[15][i], l1 = P.in[15][2048 + i]; small[SM_LB + i] = 1.0f / (1.0f + __expf(l0 - l1)); }
    for (int idx = tid; idx < 17 * 1024; idx += 512) { const int j = idx >> 10, k = idx & 1023; const float v = j < 16 ? c[j * 1024 + k] : cc[k]; sc[idx] = v / (1.0f + __expf(-v)); }
    __syncthreads();
    for (int item = blockIdx.x; item < 288; item += gridDim.x) {
        const int l = item / 144, nb = item - l * 144;
        gemv17_item(sc, red, wm + (size_t)l * 1024 * NMOD + nb * 64 + 4 * (tid & 15), NMOD, small + SM_MOD + (size_t)l * 17 * NMOD + nb * 64, NMOD, bm + l * NMOD + nb * 64, mk_wid);
    }
}
__device__ __forceinline__ void bias_phase(unsigned char* lds, const Params& P, int layer, const int mk_wid, int wg0 = 0) {
    float* sc = (float*)lds; float* red = sc + 17 * 1024; const int tid = mk_tid(mk_wid);
    float* small = (float*)(P.ws + WS_SMALL); const float* modl = small + SM_MOD + (size_t)layer * 17 * NMOD;
    const int nmix = layer == 0 ? 32 : 80; const int nitems = 88 + nmix + 88;
    int staged = -1;
    for (int item = (int)blockIdx.x - wg0; item >= 0 && item < nitems; item += (int)gridDim.x - wg0) {
        const int which = item < 88 ? 0 : (item < 88 + nmix ? 1 : 2); const int nb = which == 0 ? item : (which == 1 ? item - 88 : item - 88 - nmix);
        if (staged != which) {
            __syncthreads();
            for (int idx = tid; idx < 17 * 1024; idx += 512) { const int j = idx >> 10, k = idx & 1023; sc[idx] = modl[(size_t)j * NMOD + (3 * which) * 1024 + k]; }
            __syncthreads(); staged = which;
        }
        const int rho = nb * 64 + 4 * (tid & 15);
        const float* wsrc; size_t ld; float* outp;
        if (which == 1) { ld = layer == 0 ? 2048 : 5120; wsrc = (layer == 0 ? P.in[9] : P.in[14]) + rho; outp = small + SM_BIAS_MIX + nb * 64; }
        else {
            ld = 5632; wsrc = P.in[7] + (size_t)(layer * 2 + (which == 2 ? 1 : 0)) * 1024 * 5632 + (((rho >> 4) & 1) * DFF + 16 * (rho >> 5) + (rho & 15));
            outp = small + (which == 0 ? SM_BIAS_UPA : SM_BIAS_UPB) + nb * 64;
        }
        gemv17_item(sc, red, wsrc, ld, outp, ld, nullptr, mk_wid);
    }
    if (layer == 0) {
        const float* ng = P.in[6];
        for (int i = blockIdx.x * 512 + tid; i < 6 * 17 * 1024; i += gridDim.x * 512) {
            const int s = i / (17 * 1024), rem = i - s * 17 * 1024, j = rem >> 10, c = rem & 1023, l = s / 3, k = s - 3 * l;
            small[SM_GAM + i] = ng[s * 1024 + c] * (1.0f + small[SM_MOD + ((size_t)l * 17 + j) * NMOD + (3 * k + 1) * 1024 + c]);
        }
    }
}

__device__ __forceinline__ float wave_sum(float v) {
#pragma unroll
    for (int o = 32; o >= 1; o >>= 1) v += __shfl_xor(v, o);
    return v;
}
__device__ __forceinline__ void prenorm_phase(const float* hl, const float* hc, const float* g, const float* modl, int sc_idx, bf16_t* xn, float* rss, int nrows, const int mk_wid) {
    const int lane = mk_tid(mk_wid) & 63; const int gw = blockIdx.x * 8 + (mk_tid(mk_wid) >> 6), nw = gridDim.x * 8;
    for (int row0 = 2 * gw; row0 < nrows; row0 += 2 * nw) {
        f32x4 v[2][4]; float ss[2];
#pragma unroll
        for (int rr = 0; rr < 2; ++rr) {
            const int row = row0 + rr; const bool lat = row < NLAT; const float* src = lat ? hl + (size_t)row * D : hc + (size_t)(row - NLAT) * D;
#pragma unroll
            for (int i = 0; i < 4; ++i) v[rr][i] = *(const f32x4*)(src + i * 256 + lane * 4);
        }
#pragma unroll
        for (int rr = 0; rr < 2; ++rr) {
            float s = 0.f;
#pragma unroll
            for (int i = 0; i < 4; ++i) s += v[rr][i][0] * v[rr][i][0] + v[rr][i][1] * v[rr][i][1] + v[rr][i][2] * v[rr][i][2] + v[rr][i][3] * v[rr][i][3];
            ss[rr] = wave_sum(s);
        }
#pragma unroll
        for (int rr = 0; rr < 2; ++rr) {
            const int row = row0 + rr; const int j = row < NLAT ? (row >> 11) : 16;
            const float* scp = modl + (size_t)j * NMOD + sc_idx * 1024;
            if (lane < 16) rss[(size_t)row * 16 + lane] = lane == 0 ? ss[rr] : 0.f;
#pragma unroll
            for (int i = 0; i < 4; ++i) {
                const int cidx = i * 256 + lane * 4;
                const f32x4 gg = *(const f32x4*)(g + cidx), s1 = *(const f32x4*)(scp + cidx);
                const f32x4 y = v[rr][i] * gg * (s1 + 1.0f);
                u32x2 w; w.x = pk2(y[0], y[1]); w.y = pk2(y[2], y[3]); *(u32x2*)(xn + (size_t)row * D + cidx) = w;
            }
        }
    }
}
__device__ __forceinline__ void ctx_emit_phase(float* hc, const float* parts, const float* gamc, bf16_t* xn, float* rss, const int mk_wid) {
    const int lane = mk_tid(mk_wid) & 63; const int gw = blockIdx.x * 8 + (mk_tid(mk_wid) >> 6), nw = gridDim.x * 8;
    for (int rc = gw; rc < NCTX; rc += nw) {
        float* src = hc + (size_t)rc * D; const int row = NLAT + rc;
        f32x4 v[4]; float ss = 0.f;
#pragma unroll
        for (int i = 0; i < 4; ++i) {
            const size_t o = (size_t)rc * D + i * 256 + lane * 4;
            v[i] = *(const f32x4*)(src + i * 256 + lane * 4) + ((*(const f32x4*)(parts + o) + *(const f32x4*)(parts + (size_t)NCTX * D + o)) + (*(const f32x4*)(parts + 2 * (size_t)NCTX * D + o) + *(const f32x4*)(parts + 3 * (size_t)NCTX * D + o)));
            ss += v[i][0] * v[i][0] + v[i][1] * v[i][1] + v[i][2] * v[i][2] + v[i][3] * v[i][3];
        }
        ss = wave_sum(ss);
        if (lane < 16) rss[(size_t)row * 16 + lane] = lane == 0 ? ss : 0.f;
#pragma unroll
        for (int i = 0; i < 4; ++i) {
            const int cidx = i * 256 + lane * 4;
            *(f32x4*)(src + cidx) = v[i];
            const f32x4 y = v[i] * *(const f32x4*)(gamc + cidx);
            u32x2 w; w.x = pk2(y[0], y[1]); w.y = pk2(y[2], y[3]); *(u32x2*)(xn + (size_t)row * D + cidx) = w;
        }
    }
}
__device__ __forceinline__ void final_norm_phase(float* h, const float* g, const int mk_wid) {
    const int lane = mk_tid(mk_wid) & 63; const int gw = blockIdx.x * 8 + (mk_tid(mk_wid) >> 6), nw = gridDim.x * 8;
    for (int row0 = 2 * gw; row0 < NLAT; row0 += 2 * nw) {
        f32x4 v[2][4]; float r[2];
#pragma unroll
        for (int rr = 0; rr < 2; ++rr)
#pragma unroll
            for (int i = 0; i < 4; ++i) v[rr][i] = *(const f32x4*)(h + (size_t)(row0 + rr) * D + i * 256 + lane * 4);
#pragma unroll
        for (int rr = 0; rr < 2; ++rr) {
            float s = 0.f;
#pragma unroll
            for (int i = 0; i < 4; ++i) s += v[rr][i][0] * v[rr][i][0] + v[rr][i][1] * v[rr][i][1] + v[rr][i][2] * v[rr][i][2] + v[rr][i][3] * v[rr][i][3];
            r[rr] = rsqrtf(wave_sum(s) * (1.0f / 1024.0f) + EPS);
        }
#pragma unroll
        for (int rr = 0; rr < 2; ++rr)
#pragma unroll
            for (int i = 0; i < 4; ++i) { const int cidx = i * 256 + lane * 4; const f32x4 gg = *(const f32x4*)(g + cidx); *(f32x4*)(h + (size_t)(row0 + rr) * D + cidx) = v[rr][i] * r[rr] * gg; }
    }
}
__device__ __forceinline__ void readout_phase(const bf16_t* planes, const float* gnorm, bf16_t* dst, const int mk_wid) {
    const int lane = mk_tid(mk_wid) & 63; const int gw = blockIdx.x * 8 + (mk_tid(mk_wid) >> 6), nw = gridDim.x * 8;
    const int c0 = lane * 16;
    float gn[16];
#pragma unroll
    for (int e = 0; e < 16; ++e) gn[e] = gnorm[(c0 + e) & 127];
    for (int row0 = 2 * gw; row0 < NLAT; row0 += 2 * nw) {
        u32x4 a0[2], a1[2], b0[2], b1[2], g0[2], g1[2];
#pragma unroll
        for (int rr = 0; rr < 2; ++rr) {
            const size_t off = (size_t)(row0 + rr) * 1024 + c0;
            a0[rr] = *(const u32x4*)(planes + 2 * PLANE + off); a1[rr] = *(const u32x4*)(planes + 2 * PLANE + off + 8);
            b0[rr] = *(const u32x4*)(planes + 3 * PLANE + off); b1[rr] = *(const u32x4*)(planes + 3 * PLANE + off + 8);
            g0[rr] = *(const u32x4*)(planes + 4 * PLANE + off); g1[rr] = *(const u32x4*)(planes + 4 * PLANE + off + 8);
        }
#pragma unroll
        for (int rr = 0; rr < 2; ++rr) {
            const size_t off = (size_t)(row0 + rr) * 1024 + c0;
            float o[16], sg[16]; float ss = 0.f;
#pragma unroll
            for (int q = 0; q < 4; ++q) {
                o[2 * q] = bflo(a0[rr][q]) + bflo(b0[rr][q]); o[2 * q + 1] = bfhi(a0[rr][q]) + bfhi(b0[rr][q]);
                o[8 + 2 * q] = bflo(a1[rr][q]) + bflo(b1[rr][q]); o[8 + 2 * q + 1] = bfhi(a1[rr][q]) + bfhi(b1[rr][q]);
                sg[2 * q] = bflo(g0[rr][q]); sg[2 * q + 1] = bfhi(g0[rr][q]); sg[8 + 2 * q] = bflo(g1[rr][q]); sg[8 + 2 * q + 1] = bfhi(g1[rr][q]);
            }
#pragma unroll
            for (int e = 0; e < 16; ++e) ss += o[e] * o[e];
            ss += __shfl_xor(ss, 1); ss += __shfl_xor(ss, 2); ss += __shfl_xor(ss, 4);
            const float r = rsqrtf(ss * (1.0f / 128.0f) + EPS);
            u32x4 w0, w1;
#pragma unroll
            for (int q = 0; q < 4; ++q) {
                w0[q] = pk2(o[2 * q] * r * gn[2 * q] * sg[2 * q], o[2 * q + 1] * r * gn[2 * q + 1] * sg[2 * q + 1]);
                w1[q] = pk2(o[8 + 2 * q] * r * gn[8 + 2 * q] * sg[8 + 2 * q], o[8 + 2 * q + 1] * r * gn[8 + 2 * q + 1] * sg[8 + 2 * q + 1]);
            }
            *(u32x4*)(dst + off) = w0; *(u32x4*)(dst + off + 8) = w1;
        }
    }
}

constexpr int KS_LD = 72, VS_LD = 264;
__device__ __forceinline__ void attn_softmax16(f32x4 (&s)[16], float& mx_out, float& sum_out) {
    float mx = -1e30f;
#pragma unroll
    for (int kt = 0; kt < 16; ++kt) mx = fmaxf(fmaxf(fmaxf(s[kt][0], s[kt][1]), fmaxf(s[kt][2], s[kt][3])), mx);
    mx = fmaxf(mx, __shfl_xor(mx, 16)); mx = fmaxf(mx, __shfl_xor(mx, 32));
    float sum = 0.f;
#pragma unroll
    for (int kt = 0; kt < 16; ++kt) {
#pragma unroll
        for (int j = 0; j < 4; ++j) { const float p = __expf(s[kt][j] - mx); s[kt][j] = p; sum += p; }
    }
    sum += __shfl_xor(sum, 16); sum += __shfl_xor(sum, 32);
    mx_out = mx; sum_out = sum;
}
__device__ __forceinline__ bf16x8 attn_pfrag(const f32x4 (&s)[16], int i) {
    return mkfrag(pk2(s[2 * i][0], s[2 * i][1]), pk2(s[2 * i][2], s[2 * i][3]), pk2(s[2 * i + 1][0], s[2 * i + 1][1]), pk2(s[2 * i + 1][2], s[2 * i + 1][3]));
}
__device__ __forceinline__ void attn_ctx_half(const bf16_t* Ks, const bf16_t* Vs, const bf16x8 (&qf)[2], int lane, float& mx_out, float& sum_out, f32x4 (&o)[4]) {
    const int l15 = lane & 15, g = lane >> 4;
    f32x4 s[16];
#pragma unroll
    for (int kt = 0; kt < 16; ++kt) {
        const bf16_t* kp = Ks + (16 * kt + l15) * KS_LD + 8 * g;
        const bf16x8 k0 = *(const bf16x8*)kp, k1 = *(const bf16x8*)(kp + 32);
        f32x4 a = {0.f, 0.f, 0.f, 0.f};
        a = MFMA16(k0, qf[0], a); a = MFMA16(k1, qf[1], a);
        s[kt] = a;
    }
    attn_softmax16(s, mx_out, sum_out);
#pragma unroll
    for (int mt = 0; mt < 4; ++mt) o[mt] = (f32x4){0.f, 0.f, 0.f, 0.f};
#pragma unroll
    for (int i = 0; i < 8; ++i) {
        const bf16x8 pb = attn_pfrag(s, i);
#pragma unroll
        for (int mt = 0; mt < 4; ++mt) {
            const bf16_t* vp = Vs + (16 * mt + l15) * VS_LD + 32 * i + 4 * g;
            const u32x2 lo = *(const u32x2*)vp, hi = *(const u32x2*)(vp + 16);
            o[mt] = MFMA16(mkfrag(lo.x, lo.y, hi.x, hi.y), pb, o[mt]);
        }
    }
}
__device__ __forceinline__ void attn_ctx_tile(const bf16_t* big, bf16_t* cat, const bf16_t* Ks, const bf16_t* Vs, int b, int h, int qt, int lane) {
    const int l15 = lane & 15, g = lane >> 4;
    const int qrow = NLAT + b * CTXL + 16 * qt + l15;
    bf16x8 qf[2];
#pragma unroll
    for (int ks = 0; ks < 2; ++ks) qf[ks] = *(const bf16x8*)(big + AB_Q + (size_t)qrow * 512 + h * 64 + 32 * ks + 8 * g);
    float m2, l2; f32x4 o[4];
    attn_ctx_half(Ks, Vs, qf, lane, m2, l2, o);
    const float inv = 1.0f / l2;
    bf16_t* op = cat + (size_t)qrow * 1024 + h * 64 + 4 * g;
#pragma unroll
    for (int mt = 0; mt < 4; ++mt) { u32x2 w; w.x = pk2(o[mt][0] * inv, o[mt][1] * inv); w.y = pk2(o[mt][2] * inv, o[mt][3] * inv); *(u32x2*)(op + 16 * mt) = w; }
}
__device__ __forceinline__ void attn_lat_tile(const bf16_t* big, bf16_t* cat, const bf16_t* Ks, const bf16_t* Vs, const float* rp, int b, int h, int r, int n, int lane) {
    const int l15 = lane & 15, g = lane >> 4;
    const int qrow = b * SEQ + r * 64 + 16 * n + l15;
    const int r0 = min(max(r - 4, 0), 24), band0 = min(max(16 * n - 8, 0), 32);
    bf16x8 qf[2];
#pragma unroll
    for (int ks = 0; ks < 2; ++ks) qf[ks] = *(const bf16x8*)(big + AB_Q + (size_t)qrow * 512 + h * 64 + 32 * ks + 8 * g);
    const bf16_t* kbase = big + AB_K + (size_t)(b * SEQ + r0 * 64 + band0 + l15) * 512 + h * 64 + 8 * g;
    bf16x8 kA[8], kB[8];
#define ATT_KLOAD(dst, k0) do { _Pragma("unroll") for (int kk = 0; kk < 4; ++kk) { const int kt_ = (k0) + kk; const bf16_t* kp = kbase + (size_t)((kt_ >> 1) * 64 + 16 * (kt_ & 1)) * 512; \
        dst[2 * kk] = *(const bf16x8*)kp; dst[2 * kk + 1] = *(const bf16x8*)(kp + 32); } } while (0)
#define ATT_QK(src, k0) do { _Pragma("unroll") for (int kk = 0; kk < 4; ++kk) { f32x4 a = {0.f, 0.f, 0.f, 0.f}; a = MFMA16(src[2 * kk], qf[0], a); a = MFMA16(src[2 * kk + 1], qf[1], a); s[(k0) + kk] = a; } } while (0)
    ATT_KLOAD(kA, 0);
    __builtin_amdgcn_sched_barrier(0);
    float m2, l2; f32x4 o2[4];
    attn_ctx_half(Ks, Vs, qf, lane, m2, l2, o2);
    __builtin_amdgcn_sched_barrier(0);
    ATT_KLOAD(kB, 4);
    __builtin_amdgcn_sched_barrier(0);
    f32x4 s[16];
    ATT_QK(kA, 0);
    ATT_KLOAD(kA, 8);
    __builtin_amdgcn_sched_barrier(0);
    ATT_QK(kB, 4);
    ATT_KLOAD(kB, 12);
    __builtin_amdgcn_sched_barrier(0);
    const bf16_t* vbase = big + AB_VTL + ((size_t)b * 512 + h * 64 + l15) * SEQ + r0 * 64 + band0 + 4 * g;
    u32x2 vG[4][8];
#define ATT_VLOAD(dst, i0) do { _Pragma("unroll") for (int mt = 0; mt < 4; ++mt) { \
        const bf16_t* vp = vbase + (size_t)(16 * mt) * SEQ + (i0) * 64; dst[mt * 2] = *(const u32x2*)vp; dst[mt * 2 + 1] = *(const u32x2*)(vp + 16); } } while (0)
#define ATT_PV(src, i0) do { const bf16x8 pb = attn_pfrag(s, (i0)); _Pragma("unroll") for (int mt = 0; mt < 4; ++mt) \
        o1[mt] = MFMA16(mkfrag(src[mt * 2].x, src[mt * 2].y, src[mt * 2 + 1].x, src[mt * 2 + 1].y), pb, o1[mt]); } while (0)
    ATT_QK(kA, 8);
    __builtin_amdgcn_sched_barrier(0);
    ATT_QK(kB, 12);
    __builtin_amdgcn_sched_barrier(0);
#pragma unroll
    for (int i = 0; i < 4; ++i) ATT_VLOAD(vG[i], i);
    __builtin_amdgcn_sched_barrier(0);
#undef ATT_KLOAD
#undef ATT_QK
    {
        const int cq = 16 * n + l15; const int wc0 = min(max(cq - 8, 0), 48);
#pragma unroll
        for (int kt = 0; kt < 16; ++kt) {
            const int rowi = r0 + (kt >> 1) - r + 7;
#pragma unroll
            for (int j = 0; j < 4; ++j) {
                const int kcol = band0 + 16 * (kt & 1) + 4 * g + j;
                const bool ok = (kcol >= wc0) && (kcol < wc0 + 16);
                const int rel = min(max(kcol - cq, -15), 15) + 15;
                const float bias = rp[rowi * 31 + rel];
                s[kt][j] = ok ? s[kt][j] + bias : -1e30f;
            }
        }
    }
    float m1, l1; attn_softmax16(s, m1, l1);
    f32x4 o1[4];
#pragma unroll
    for (int mt = 0; mt < 4; ++mt) o1[mt] = (f32x4){0.f, 0.f, 0.f, 0.f};
#pragma unroll
    for (int i = 0; i < 4; ++i) ATT_PV(vG[i], i);
    __builtin_amdgcn_sched_barrier(0);
#pragma unroll
    for (int i = 0; i < 4; ++i) ATT_VLOAD(vG[i], 4 + i);
    __builtin_amdgcn_sched_barrier(0);
#pragma unroll
    for (int i = 0; i < 4; ++i) ATT_PV(vG[i], 4 + i);
#undef ATT_VLOAD
#undef ATT_PV
    const float m = fmaxf(m1, m2); const float a1 = __expf(m1 - m), a2 = __expf(m2 - m);
    const float inv = 1.0f / (l2 * a2 + l1 * a1);
    bf16_t* op = cat + (size_t)qrow * 1024 + h * 64 + 4 * g;
#pragma unroll
    for (int mt = 0; mt < 4; ++mt) {
        const f32x4 ov = (o2[mt] * a2 + o1[mt] * a1) * inv;
        u32x2 w; w.x = pk2(ov[0], ov[1]); w.y = pk2(ov[2], ov[3]); *(u32x2*)(op + 16 * mt) = w;
    }
}
__device__ __forceinline__ void mixer_ab_phase(unsigned char* lds, const Params& P, const int mk_wid) {
    bf16_t* Ks = (bf16_t*)lds;
    bf16_t* Vs = Ks + 256 * KS_LD;
    float* rpbs = (float*)(Vs + 64 * VS_LD);
    const bf16_t* big = (const bf16_t*)(P.ws + WS_BIG); bf16_t* cat = (bf16_t*)(P.ws + WS_XN);
    const int tid = mk_tid(mk_wid), lane = tid & 63, w = tid >> 6;
    for (int item = blockIdx.x; item < 256; item += gridDim.x) {
        const int half = item & 1, h = (item >> 1) & 7, b = item >> 4;
        __syncthreads();
#pragma unroll
        for (int i = 0; i < 4; ++i) {
            const int q = tid + 512 * i;
            { const int row = q >> 3, part = q & 7; *(u32x4*)(Ks + row * KS_LD + part * 8) = *(const u32x4*)(big + AB_K + (size_t)(NLAT + b * CTXL + row) * 512 + h * 64 + part * 8); }
            { const int d = q >> 5, part = q & 31; *(u32x4*)(Vs + d * VS_LD + part * 8) = *(const u32x4*)(big + AB_VTC + ((size_t)b * 512 + h * 64 + d) * CTXL + part * 8); }
        }
        if (tid < 465) rpbs[tid] = P.in[10][h * 465 + tid];
        __syncthreads();
        for (int it = 0; it < 8; ++it) attn_lat_tile(big, cat, Ks, Vs, rpbs, b, h, half * 16 + 2 * it + (w >> 2), w & 3, lane);
        attn_ctx_tile(big, cat, Ks, Vs, b, h, half * 8 + w, lane);
    }
    __syncthreads();
    const bf16_t* U = big + AB_U;
    for (int idx = blockIdx.x * 512 + tid; idx < T * 64; idx += gridDim.x * 512) {
        const int row = idx >> 6, c8 = idx & 63, ch = c8 * 8, grp = c8 >> 4, wd = 2 << grp, hf = wd >> 1;
        int base, L, t;
        if (row < NLAT) { base = row & ~2047; L = SEQ; t = row & 2047; } else { const int rc = row - NLAT; base = NLAT + (rc & ~255); L = CTXL; t = rc & 255; }
        const int lo = max(t - hf, 0), hi = min(t - hf + wd, L);
        float acc[8];
#pragma unroll
        for (int e = 0; e < 8; ++e) acc[e] = 0.f;
#pragma unroll
        for (int i = 0; i < 16; ++i) {
            const int tt = lo + i;
            u32x4 v = {0u, 0u, 0u, 0u};
            if (tt < hi) v = *(const u32x4*)(U + (size_t)(base + tt) * 512 + ch);
#pragma unroll
            for (int q = 0; q < 4; ++q) { acc[2 * q] += bflo(v[q]); acc[2 * q + 1] += bfhi(v[q]); }
        }
        const u32x4 sv = *(const u32x4*)(U + (size_t)row * 512 + ch);
        const float invn = 1.0f / (float)(hi - lo);
        u32x4 w4;
#pragma unroll
        for (int q = 0; q < 4; ++q) w4[q] = pk2(acc[2 * q] * invn - bflo(sv[q]), acc[2 * q + 1] * invn - bfhi(sv[q]));
        *(u32x4*)(cat + (size_t)row * 1024 + 512 + ch) = w4;
    }
}

__device__ __forceinline__ void scan_phase(unsigned char* lds, const Params& P, const int mk_wid) {
    constexpr int RLD = 136, RT = 32 * RLD;
    bf16_t* Raw = (bf16_t*)lds;
    float* Pt = (float*)(lds + 2 * 3 * RT * 2);
    float* EG = Pt + 512;
    bf16_t* Qh = (bf16_t*)(EG + 128);
    bf16_t* Qt = Qh + RT;
    bf16_t* Kt = Qt + RT;
    bf16_t* KhT = Kt + RT;
    bf16_t* VT = KhT + 128 * 40;
    bf16_t* Am = VT + 128 * 40;
    bf16_t* Os = Am + 32 * 40;
    bf16_t* planes = (bf16_t*)(P.ws + WS_BIG);
    const int tid = mk_tid(mk_wid), lane = tid & 63, w = tid >> 6, g = lane >> 4, l15 = lane & 15;
    const int lp = tid >> 4, c8 = tid & 15;
    const int ch = tid & 127, pg = tid >> 7;
    for (int chain = blockIdx.x; chain < 256; chain += gridDim.x) {
        const int dir = chain & 1, h = (chain >> 1) & 7, b = chain >> 4;
        const int col = h * 128 + 8 * c8; const int sgn = dir ? -1 : 1;
        const bf16_t* qpl = planes; const bf16_t* ipl = planes + PLANE; bf16_t* fpl = planes + (size_t)(2 + dir) * PLANE;
        f32x4 S[8];
#pragma unroll
        for (int m = 0; m < 8; ++m) S[m] = (f32x4){0.f, 0.f, 0.f, 0.f};
#define SCAN_R0(c) ((c) >= 8 ? (b * SEQ + (dir ? SEQ - 1 - 32 * ((c) - 8) : 32 * ((c) - 8))) : (NLAT + b * CTXL + (dir ? CTXL - 1 - 32 * (c) : 32 * (c))))
        u32x4 nk, nv, nq; nq = (u32x4){0u, 0u, 0u, 0u};
        __syncthreads();
        { const size_t off = (size_t)(SCAN_R0(0) + sgn * lp) * 1024 + col; nk = *(const u32x4*)(fpl + off); nv = *(const u32x4*)(ipl + off); }
        *(u32x4*)(Raw + 0 * RT + lp * RLD + 8 * c8) = nk; *(u32x4*)(Raw + 1 * RT + lp * RLD + 8 * c8) = nv;
        { const size_t off = (size_t)(SCAN_R0(1) + sgn * lp) * 1024 + col; nk = *(const u32x4*)(fpl + off); nv = *(const u32x4*)(ipl + off); }
        __syncthreads();
        for (int c = 0; c < 72; ++c) {
            const bool need_o = c >= 8;
            const bf16_t* raw = Raw + (c & 1) * 3 * RT;
            float kk[8], loc[8]; unsigned vb[8]; float qv[8];
            {
                float f[8];
#pragma unroll
                for (int i = 0; i < 8; ++i) { kk[i] = bf2f(raw[(8 * pg + i) * RLD + ch]); f[i] = 1.0f - kk[i]; vb[i] = raw[RT + (8 * pg + i) * RLD + ch]; qv[i] = need_o ? bf2f(raw[2 * RT + (8 * pg + i) * RLD + ch]) : 0.f; }
                float s = 1.0f;
                if (pg < 2) {
#pragma unroll
                    for (int i = 7; i >= 0; --i) { loc[i] = s; s *= f[i]; }
                } else {
#pragma unroll
                    for (int i = 0; i < 8; ++i) { s *= f[i]; loc[i] = s; }
                }
                Pt[pg * 128 + ch] = s;
            }
            __syncthreads();
            {
                const float P0 = Pt[ch], P1 = Pt[128 + ch], P2 = Pt[256 + ch], P3 = Pt[384 + ch];
                const float T1 = P0 * P1, T2 = P2 * P3;
                const float mult = pg == 0 ? P1 : (pg == 3 ? P2 : 1.0f);
                float kh[8], qh[8], qt[8], kt[8];
#pragma unroll
                for (int i = 0; i < 8; ++i) {
                    const float X = loc[i] * mult; const float rX = __builtin_amdgcn_rcpf(X);
                    const float up = pg < 2 ? rX : X, dn = pg < 2 ? X : rX;
                    qt[i] = qv[i] * up; kt[i] = kk[i] * dn; qh[i] = qt[i] * T1; kh[i] = kt[i] * T2;
                }
                *(u32x4*)(KhT + ch * 40 + 8 * pg) = (u32x4){pk2(kh[0], kh[1]), pk2(kh[2], kh[3]), pk2(kh[4], kh[5]), pk2(kh[6], kh[7])};
                *(u32x4*)(VT + ch * 40 + 8 * pg) = (u32x4){vb[0] | (vb[1] << 16), vb[2] | (vb[3] << 16), vb[4] | (vb[5] << 16), vb[6] | (vb[7] << 16)};
                if (pg == 0) EG[ch] = T1 * T2;
                if (need_o) {
#pragma unroll
                    for (int i = 0; i < 8; ++i) { Qh[(8 * pg + i) * RLD + ch] = f2bf(qh[i]); Qt[(8 * pg + i) * RLD + ch] = f2bf(qt[i]); Kt[(8 * pg + i) * RLD + ch] = f2bf(kt[i]); }
                }
            }
            if (c > 8) *(u32x4*)(fpl + (size_t)(SCAN_R0(c - 1) + sgn * lp) * 1024 + col) = *(const u32x4*)(Os + lp * RLD + 8 * c8);
            __syncthreads();
            if (c + 1 < 72) {
                bf16_t* rn = Raw + ((c + 1) & 1) * 3 * RT + lp * RLD + 8 * c8;
                *(u32x4*)rn = nk; *(u32x4*)(rn + RT) = nv; if (c + 1 >= 8) *(u32x4*)(rn + 2 * RT) = nq;
                if (c + 2 < 72) {
                    const size_t off = (size_t)(SCAN_R0(c + 2) + sgn * lp) * 1024 + col;
                    nk = *(const u32x4*)(fpl + off); nv = *(const u32x4*)(ipl + off); if (c + 2 >= 8) nq = *(const u32x4*)(qpl + off);
                }
            }
            const bf16x8 bv = *(const bf16x8*)(VT + (16 * w + l15) * 40 + 8 * g);
            f32x4 o[2]; o[0] = (f32x4){0.f, 0.f, 0.f, 0.f}; o[1] = (f32x4){0.f, 0.f, 0.f, 0.f};
            if (need_o) {
#pragma unroll
                for (int ks = 0; ks < 4; ++ks) {
                    const bf16x8 sb = mkfrag(pk2(S[2 * ks][0], S[2 * ks][1]), pk2(S[2 * ks][2], S[2 * ks][3]), pk2(S[2 * ks + 1][0], S[2 * ks + 1][1]), pk2(S[2 * ks + 1][2], S[2 * ks + 1][3]));
#pragma unroll
                    for (int mt = 0; mt < 2; ++mt) {
                        const bf16_t* ap = Qh + (16 * mt + l15) * RLD + 32 * ks + 4 * g;
                        const u32x2 lo = *(const u32x2*)ap, hi = *(const u32x2*)(ap + 16);
                        o[mt] = MFMA16(mkfrag(lo.x, lo.y, hi.x, hi.y), sb, o[mt]);
                    }
                }
                if (w < 4) {
                    const int tm = w >> 1, sn = w & 1; f32x4 a = {0.f, 0.f, 0.f, 0.f};
                    if (!(tm == 0 && sn == 1)) {
#pragma unroll
                        for (int ks = 0; ks < 4; ++ks) {
                            const bf16x8 af = *(const bf16x8*)(Qt + (16 * tm + l15) * RLD + 32 * ks + 8 * g);
                            const bf16x8 bf = *(const bf16x8*)(Kt + (16 * sn + l15) * RLD + 32 * ks + 8 * g);
                            a = MFMA16(af, bf, a);
                        }
                    }
                    const int s_ = 16 * sn + l15;
#pragma unroll
                    for (int j = 0; j < 4; ++j) { const int t_ = 16 * tm + 4 * g + j; Am[t_ * 40 + s_] = f2bf(s_ <= t_ ? a[j] : 0.f); }
                }
            }
            __syncthreads();
            if (need_o) {
#pragma unroll
                for (int mt = 0; mt < 2; ++mt) { const bf16x8 af = *(const bf16x8*)(Am + (16 * mt + l15) * 40 + 8 * g); o[mt] = MFMA16(af, bv, o[mt]); }
#pragma unroll
                for (int mt = 0; mt < 2; ++mt)
#pragma unroll
                    for (int j = 0; j < 4; ++j) Os[(16 * mt + 4 * g + j) * RLD + 16 * w + l15] = f2bf(o[mt][j]);
            }
#pragma unroll
            for (int m = 0; m < 8; ++m) {
                const f32x4 eg = *(const f32x4*)(EG + 16 * m + 4 * g);
                const bf16x8 af = *(const bf16x8*)(KhT + (16 * m + l15) * 40 + 8 * g);
                S[m] = MFMA16(af, bv, S[m] * eg);
            }
        }
        __syncthreads();
        *(u32x4*)(fpl + (size_t)(SCAN_R0(71) + sgn * lp) * 1024 + col) = *(const u32x4*)(Os + lp * RLD + 8 * c8);
#undef SCAN_R0
    }
    __syncthreads();
}

__device__ __forceinline__ void grid_bar(unsigned* cnt, unsigned target, const int mk_wid) {
    __syncthreads();
    if (mk_tid(mk_wid) == 0) {
        __builtin_amdgcn_fence(__ATOMIC_RELEASE, "agent");
        __hip_atomic_fetch_add(cnt, 1u, __ATOMIC_RELAXED, __HIP_MEMORY_SCOPE_AGENT);
        while (__hip_atomic_load(cnt, __ATOMIC_RELAXED, __HIP_MEMORY_SCOPE_AGENT) < target) __builtin_amdgcn_s_sleep(8);
        __builtin_amdgcn_fence(__ATOMIC_ACQUIRE, "agent");
    }
    __syncthreads();
}
#define XB_TMO      128
#define XB_XCNT(j)  (256  + 64 * (j))
#define XB_XSUB(j)  (1280 + 64 * (j))
#define XB_XGEN(j)  (2304 + 64 * (j))
#define XB_TOP      3328
#define XB_TOPGEN   3392
#define XCD_BAR_WORDS 3456
#define XB_SPIN_CAP (1u << 18)
#define LAS __attribute__((address_space(3)))

__device__ __forceinline__ unsigned xb_ld(unsigned* p)              { return __hip_atomic_load(p, __ATOMIC_RELAXED, __HIP_MEMORY_SCOPE_AGENT); }
__device__ __forceinline__ unsigned xb_add(unsigned* p, unsigned v) { return __hip_atomic_fetch_add(p, v, __ATOMIC_RELAXED, __HIP_MEMORY_SCOPE_AGENT); }
__device__ __forceinline__ unsigned xb_xcc_id() { return (unsigned)__builtin_amdgcn_s_getreg((3 << 11) | 20) & 0xFu; }
#define XB_SPIN(cond, bar) do { unsigned _sp = 0; while (cond) { __builtin_amdgcn_s_sleep(1); \
    if ((++_sp & 255u) == 0u) { if (xb_ld(&(bar)[XB_TMO])) break; if (_sp > XB_SPIN_CAP) { atomicAdd(&(bar)[XB_TMO], 1u); break; } } } } while (0)

struct XcdBarrier {
    unsigned* bar; unsigned x;
    volatile LAS unsigned* st;
};

__device__ __forceinline__ XcdBarrier xcd_barrier_post(unsigned* bar, volatile LAS unsigned* st, const int mk_wid) {
    XcdBarrier b; b.bar = bar; b.x = xb_xcc_id(); b.st = st;
    if (mk_tid(mk_wid) == 0) (void)xb_add(&bar[XB_XCNT(b.x)], 1u);
    return b;
}
__device__ __forceinline__ void xcd_barrier_complete(unsigned* bar, unsigned x, unsigned& nloc, unsigned& nx) {
    const unsigned G = gridDim.x * gridDim.y * gridDim.z;
    unsigned sum, cnt, mine, sp = 0u;
    for (;;) {
        sum = 0u; cnt = 0u; mine = 0u;
#pragma unroll
        for (unsigned j = 0; j < 16; ++j) { const unsigned c = xb_ld(&bar[XB_XCNT(j)]); sum += c; cnt += (c > 0u) ? 1u : 0u; mine = (j == x) ? c : mine; }
        if (sum == G) break;
        __builtin_amdgcn_s_sleep(1);
        if ((++sp & 255u) == 0u) { if (xb_ld(&bar[XB_TMO])) break; if (sp > XB_SPIN_CAP) { atomicAdd(&bar[XB_TMO], 1u); break; } }
    }
    nloc = mine > 0u ? mine : 1u; nx = cnt > 0u ? cnt : 1u;
}

__device__ __forceinline__ void xcd_barrier(const XcdBarrier& b, const int mk_wid) {
    asm volatile("s_waitcnt vmcnt(0)" ::: "memory");
    __syncthreads();
    if (mk_tid(mk_wid) == 0) {
        unsigned* bar = b.bar;
        __builtin_amdgcn_s_waitcnt(0);
        unsigned nloc = b.st[0], nx = b.st[1];
        if (nloc == 0u) { xcd_barrier_complete(bar, b.x, nloc, nx); b.st[0] = nloc; b.st[1] = nx; }
        const unsigned old = xb_add(&bar[XB_XSUB(b.x)], 1u);
        const unsigned gen = old / nloc;
        if (old + 1u == (gen + 1u) * nloc) {
            __builtin_amdgcn_fence(__ATOMIC_RELEASE, "agent");
            asm volatile("s_waitcnt vmcnt(0)" ::: "memory");
            const unsigned og = xb_add(&bar[XB_TOP], 1u);
            const unsigned tg = og / nx;
            if (og + 1u == (tg + 1u) * nx) xb_add(&bar[XB_TOPGEN], 1u);
            else XB_SPIN(xb_ld(&bar[XB_TOPGEN]) == tg, bar);
            __builtin_amdgcn_fence(__ATOMIC_ACQUIRE, "agent");
            xb_add(&bar[XB_XGEN(b.x)], 1u);
            asm volatile("s_waitcnt vmcnt(0)" ::: "memory");
        } else {
            XB_SPIN(xb_ld(&bar[XB_XGEN(b.x)]) == gen, bar);
            __builtin_amdgcn_fence(__ATOMIC_ACQUIRE, "agent");
            asm volatile("s_waitcnt vmcnt(0)" ::: "memory");
        }
    }
    __syncthreads();
}


__global__ void __launch_bounds__(512) mk_fwd(Params P) {
    extern __shared__ __attribute__((aligned(16))) unsigned char lds_raw[];
    cg::grid_group grid = cg::this_grid();
    const int mk_wid = __builtin_amdgcn_readfirstlane((int)(threadIdx.x >> 6));
    PG8_LAS unsigned char* ldsg = (PG8_LAS unsigned char*)lds_raw;
    unsigned char* ws = P.ws;
    bf16_t* bt = (bf16_t*)(ws + WS_BT); float* hctx = (float*)(ws + WS_HCTX); bf16_t* xn = (bf16_t*)(ws + WS_XN);
    float* small = (float*)(ws + WS_SMALL); bf16_t* big = (bf16_t*)(ws + WS_BIG);
    const float* x = P.in[0]; const float* ctx = P.in[2]; const float* norm_g = P.in[6]; float* hl = P.out;
    const float* mod0 = small + SM_MOD; const float* mod1 = small + SM_MOD + 17 * NMOD;
#define IN(k) (P.ph_lo <= (k) && (k) < P.ph_hi)
#if PROBE_MASK
    unsigned long long ptot = 0, ptprev = __builtin_amdgcn_s_memrealtime();
#define PROBE_TICK(k) do { const unsigned long long now_ = __builtin_amdgcn_s_memrealtime(); if ((PROBE_MASK >> (k)) & 1) ptot += now_ - ptprev; ptprev = now_; } while (0)
#else
#define PROBE_TICK(k) do { } while (0)
#endif
    if (P.ph_lo < 0) grid.sync();
    { volatile PG8_LAS unsigned* st0 = (volatile PG8_LAS unsigned*)(ldsg + 131072); if (mk_tid(mk_wid) < 4) st0[mk_tid(mk_wid)] = 0u; }
    __syncthreads();
    XcdBarrier xbar = xcd_barrier_post((unsigned*)(ws + WS_BAR), (volatile PG8_LAS unsigned*)(ldsg + 131072), mk_wid);
#define SEAM(k) do { if (P.ph_lo <= (k) && (k) + 1 < P.ph_hi) xcd_barrier(xbar, mk_wid); PROBE_TICK(k); } while (0)

    bf16_t* xn2 = (bf16_t*)(ws + WS_XN2); float* rss = small + SM_RSS;
    const float* gam = small + SM_GAM;
    float* cparts = (float*)(ws + WS_BIG + 272 * MiB);
    const NormFix nfA{rss, small + SM_BIAS_UPA, 2 * DFF}, nfB{rss, small + SM_BIAS_UPB, 2 * DFF}, nfM0{rss, small + SM_BIAS_MIX, 2048}, nfM1{rss, small + SM_BIAS_MIX, 5120};
    if (IN(0)) mod_phase(lds_raw, P, mk_wid); SEAM(0);
    if (IN(1)) { prep_weights(lds_raw, P, 0, mk_wid); pool_fold(lds_raw, P, mk_wid); bias_phase(lds_raw, P, 0, mk_wid); prenorm_phase(x, ctx, norm_g, mod0, 1, xn, rss, T, mk_wid);
        for (int i = blockIdx.x * 512 + mk_tid(mk_wid); i < NCTX * D / 4; i += gridDim.x * 512) ((f32x4*)hctx)[i] = ((const f32x4*)ctx)[i];
    } SEAM(1);
    if (IN(2)) { EpiSwiGLU E{big, nfA}; run_gemm(ldsg, xn, bt + BT_W13A, T, 2 * DFF, D, E, mk_wid); } SEAM(2);
    if (IN(3)) { EpiRes<true> E{x, hctx, hl, hctx, mod0 + 2 * 1024, gam + 1 * 17 * 1024, xn, rss, cparts, 0.5f, mk_wid}; run_gemm_split(ldsg, big, bt + BT_W2A, D, DFF, E, mk_wid); } SEAM(3);
    if (IN(3)) { ctx_emit_phase(hctx, cparts, gam + (1 * 17 + 16) * 1024, xn, rss, mk_wid); xcd_barrier(xbar, mk_wid); }
    if (IN(4)) { EpiAB E{big, nfM0}; run_gemm(ldsg, xn, bt + BT_MIXIN, T, 2048, D, E, mk_wid); } SEAM(4);
    if (IN(5)) mixer_ab_phase(lds_raw, P, mk_wid); SEAM(5);
    if (IN(6)) { EpiRes<true> E{hl, hctx, hl, hctx, mod0 + 5 * 1024, gam + 2 * 17 * 1024, xn2, rss, cparts, 1.0f, mk_wid}; run_gemm_split(ldsg, xn, bt + BT_MIXOUT, D, D, E, mk_wid); } SEAM(6);
    if (IN(6)) { ctx_emit_phase(hctx, cparts, gam + (2 * 17 + 16) * 1024, xn2, rss, mk_wid); xcd_barrier(xbar, mk_wid); }
    if (IN(7)) { EpiSwiGLU E{big, nfB}; run_gemm(ldsg, xn2, bt + BT_W13B, T, 2 * DFF, D, E, mk_wid); } SEAM(7);
    if (IN(8)) { EpiRes<true> E{hl, hctx, hl, hctx, mod0 + 8 * 1024, gam + 3 * 17 * 1024, xn, rss, cparts, 0.5f, mk_wid}; run_gemm_split(ldsg, big, bt + BT_W2B, D, DFF, E, mk_wid);  prep_weights(lds_raw, P, 1, mk_wid, 0, 1264, 0); bias_phase(lds_raw, P, 1, mk_wid, 0); } SEAM(8);
    if (IN(9)) { prep_weights(lds_raw, P, 1, mk_wid, 1264, 1440, 0); ctx_emit_phase(hctx, cparts, gam + (3 * 17 + 16) * 1024, xn, rss, mk_wid); } SEAM(9);
    if (IN(10)) { EpiSwiGLU E{big, nfA}; run_gemm(ldsg, xn, bt + BT_W13A, T, 2 * DFF, D, E, mk_wid); } SEAM(10);
    if (IN(11)) { EpiRes<true> E{hl, hctx, hl, hctx, mod1 + 2 * 1024, gam + 4 * 17 * 1024, xn, rss, cparts, 0.5f, mk_wid}; run_gemm_split(ldsg, big, bt + BT_W2A, D, DFF, E, mk_wid); } SEAM(11);
    if (IN(11)) { ctx_emit_phase(hctx, cparts, gam + (4 * 17 + 16) * 1024, xn, rss, mk_wid); xcd_barrier(xbar, mk_wid); }
    if (IN(12)) { EpiHG E{big, nfM1, small + SM_LB}; run_gemm_hg(ldsg, xn, bt + BT_MIXIN, E, mk_wid); } SEAM(12);
    if (IN(13)) scan_phase(lds_raw, P, mk_wid); SEAM(13);
    if (IN(14)) readout_phase(big, P.in[16], xn, mk_wid); SEAM(14);
    if (IN(15)) { EpiRes<true> E{hl, hctx, hl, hctx, mod1 + 5 * 1024, gam + 5 * 17 * 1024, xn2, rss, cparts, 1.0f, mk_wid}; run_gemm(ldsg, xn, bt + BT_MIXOUT, NLAT, D, D, E, mk_wid); } SEAM(15);
    if (IN(16)) { EpiSwiGLU E{big, nfB}; run_gemm(ldsg, xn2, bt + BT_W13B, NLAT, 2 * DFF, D, E, mk_wid); } SEAM(16);
    if (IN(17)) { EpiRes<false> E{hl, hctx, hl, hctx, mod1 + 8 * 1024, nullptr, nullptr, nullptr, cparts, 0.5f, mk_wid}; run_gemm(ldsg, big, bt + BT_W2B, NLAT, D, DFF, E, mk_wid); } SEAM(17);
    if (IN(18)) final_norm_phase(hl, P.in[18], mk_wid);
#if PROBE_MASK
    PROBE_TICK(18);
    if (blockIdx.x == 0) { const unsigned long long tend = __builtin_amdgcn_s_memrealtime(); while (__builtin_amdgcn_s_memrealtime() - tend < (unsigned long long)PROBE_K * ptot) __builtin_amdgcn_s_sleep(32); }
#endif
#undef IN
#undef SEAM
}
}

extern "C" void kernel_launch(void* const* d_in, const int* in_sizes, int n_in, void* d_out, int out_size, void* d_ws, size_t ws_size, hipStream_t stream) {
    static int grid = 0;
    if (grid == 0) {
        if (n_in != 19 || ws_size < mk::WS_END) { fprintf(stderr, "kernel_launch: unexpected n_in %d or ws_size %zu (need %zu)\n", n_in, ws_size, (size_t)mk::WS_END); grid = -1; return; }
        int dev = 0, cus = 0, per_cu = 0;
        hipGetDevice(&dev); hipDeviceGetAttribute(&cus, hipDeviceAttributeMultiprocessorCount, dev);
        if (hipFuncSetAttribute((const void*)mk::mk_fwd, hipFuncAttributeMaxDynamicSharedMemorySize, mk::LDS_BYTES) != hipSuccess) { fprintf(stderr, "kernel_launch: hipFuncSetAttribute failed\n"); grid = -1; return; }
        if (hipOccupancyMaxActiveBlocksPerMultiprocessor(&per_cu, (const void*)mk::mk_fwd, 512, mk::LDS_BYTES) != hipSuccess || per_cu < 1) { per_cu = 1; (void)hipGetLastError(); }
        grid = cus * 1;
        (void)per_cu;
    }
    if (grid < 0) return;
    (void)hipMemsetAsync((char*)d_ws + mk::WS_BAR, 0, 16384, stream);
    mk::Params p{};
    for (int i = 0; i < 19; ++i) p.in[i] = (const float*)d_in[i];
    p.out = (float*)d_out; p.ws = (unsigned char*)d_ws;
#if MK_PER_PHASE
    for (int ph = 0; ph < mk::NPHASE; ++ph) {
        p.ph_lo = ph; p.ph_hi = ph + 1; void* args[] = {&p};
        hipError_t e = hipLaunchCooperativeKernel((const void*)mk::mk_fwd, dim3(grid), dim3(512), args, mk::LDS_BYTES, stream);
        if (e != hipSuccess) { fprintf(stderr, "cooperative launch failed: %s\n", hipGetErrorString(e)); break; }
    }
#else
    p.ph_lo = 0; p.ph_hi = mk::NPHASE; void* args[] = {&p};
    hipError_t e = hipLaunchCooperativeKernel((const void*)mk::mk_fwd, dim3(grid), dim3(512), args, mk::LDS_BYTES, stream);
    if (e != hipSuccess) fprintf(stderr, "cooperative launch failed: %s (grid %d)\n", hipGetErrorString(e), grid);
#endif
}
```

```cpp
#include <hip/hip_runtime.h>
#include <hip/hip_cooperative_groups.h>
#include <cstdio>
#include <type_traits>
namespace cg = cooperative_groups;
#define PROBE_MASK 0x0u
#define PROBE_K 4
#define PROBE_EPI 0

#ifndef MK_PER_PHASE
#define MK_PER_PHASE 0
#endif

__device__ __forceinline__ int mk_tid(int mk_wid) { int l; asm volatile("v_mbcnt_lo_u32_b32 %0, -1, 0\n\tv_mbcnt_hi_u32_b32 %0, -1, %0" : "=v"(l)); return mk_wid * 64 + l; }
namespace pg8 {
#define PG8_LAS __attribute__((address_space(3)))
typedef unsigned short bf16_t;
typedef short bf16x8 __attribute__((ext_vector_type(8)));
typedef float f32x4 __attribute__((ext_vector_type(4)));
typedef unsigned u32x4 __attribute__((ext_vector_type(4)));
constexpr int BM = 256, BK = 64, HALF = 128, HTB = HALF * BK * 2  , STAGE_BYTES = 8 * HTB, NXCD = 8, WGM = 8;

__host__ __device__ __forceinline__ int lds_byte(int r, int c) { const int st = (r >> 4) * 2 + (c >> 5), rr = r & 15, cc = c & 31, ob = rr * 64 + cc * 2; return st * 1024 + (ob ^ (((ob >> 9) & 1) << 5)); }
__host__ __device__ __forceinline__ void stage_rc(int b, int& R, int& C) { const int st = b / 1024, sb = b % 1024, swz = sb ^ (((sb >> 9) & 1) << 5); R = (st >> 1) * 16 + swz / 64; C = (st & 1) * 32 + (swz % 64) / 2; }
__host__ __device__ __forceinline__ int perm32(int rho) { const int n = rho >> 4, i = rho & 15; return 8 * (i >> 2) + 4 * n + (i & 3); }

struct Unit { int pm, pn, k0t, ntu, split; };
struct Gemm { const bf16_t* A; const bf16_t* Bt; int M, N, K; };

struct StaticOrder {
    int nM, nN, nwg, G, c;
    __host__ __device__ void init(int M, int N, int G_, int c_) { nM = M / BM; nN = N / BM; nwg = nM * nN; G = G_; c = c_; }
    __host__ __device__ bool next(int i, Unit& u) const {
        const long L = (long)i * G + c; if (L >= nwg) return false;
        int wgid = (int)L; { const int q = nwg / NXCD, r = nwg % NXCD, xcd = wgid % NXCD, off = wgid / NXCD; wgid = (xcd < r ? xcd * (q + 1) : r * (q + 1) + (xcd - r) * q) + off; }
        const int nig = WGM * nN, gid = wgid / nig, fm = gid * WGM, gsz = (nM - fm) < WGM ? (nM - fm) : WGM;
        u.pm = fm + ((wgid % nig) % gsz); u.pn = (wgid % nig) / gsz; u.k0t = 0; u.ntu = 0; u.split = 0; return true;
    }
    __device__ __forceinline__ void a_ready(const Unit&) const {}
    __device__ __forceinline__ void done(const Unit&) const {}
};

template <class Epi, class Sched, bool STAMP = false>
__device__ __forceinline__ void gemm_phase(PG8_LAS unsigned char* lds, const Gemm g, const Sched S, const Epi E, unsigned long long* stamps, const int mk_wid) {
    const int tid = mk_tid(mk_wid), wid = __builtin_amdgcn_readfirstlane(tid >> 6), lane = tid & 63, wr = wid >> 2, wc = wid & 3, fr = lane & 15, fq = lane >> 4;
    const int K = g.K, nt = K / BK;
    int ts_lo = 0, ts_hi = 0, nts = 0; const unsigned long long rt_entry = STAMP ? (unsigned long long)wall_clock64() : 0ull;
#define PG8_STAMP() do { if (STAMP && wid == 0 && nts < 64) { const unsigned long long _c = (unsigned long long)clock64(); \
        ts_lo = (lane == nts) ? (int)(unsigned)_c : ts_lo; ts_hi = (lane == nts) ? (int)(unsigned)(_c >> 32) : ts_hi; ++nts; } } while (0)
    PG8_STAMP();
    unsigned voffA[2], voffB[2];
#pragma unroll
    for (int i = 0; i < 2; ++i) { int R, C; stage_rc(tid * 16 + i * 8192, R, C); const int Rb = Epi::PERM ? ((R & ~31) + perm32(R & 31)) : R;
        voffA[i] = (unsigned)(R * K + C) * 2u; voffB[i] = (unsigned)(Rb * K + C) * 2u; }
    const size_t kstep = (size_t)(BK * 2);
    const size_t hstep = (size_t)HALF * K * 2;
    const size_t tstep = 2 * hstep;
    const unsigned ldsw = (unsigned)wid * 1024u;
    const int aoff = lds_byte(wr * 64 + fr, fq * 8), boff = lds_byte(wc * 32 + fr, fq * 8);
#define PG8_SA(b, h) (((b) * 2 + (h)) * HTB)
#define PG8_SB(b, h) ((4 + (b) * 2 + (h)) * HTB)
#define PG8_STAGE(bufoff, gbase, voff) do { _Pragma("unroll") for (int _i = 0; _i < 2; ++_i) \
        __builtin_amdgcn_global_load_lds((const unsigned*)((const char*)(gbase) + (voff)[_i]), (PG8_LAS unsigned*)(lds + (bufoff) + ldsw + _i * 8192), 16, 0, 0); } while (0)
#define PG8_LDA(dst, b, h) do { _Pragma("unroll") for (int m = 0; m < 4; ++m) _Pragma("unroll") for (int k = 0; k < 2; ++k) dst[m][k] = *(const PG8_LAS bf16x8*)(lds + PG8_SA(b, h) + aoff + m * 2048 + k * 1024); } while (0)
#define PG8_LDB(dst, b, h) do { _Pragma("unroll") for (int n = 0; n < 2; ++n) _Pragma("unroll") for (int k = 0; k < 2; ++k) dst[n][k] = *(const PG8_LAS bf16x8*)(lds + PG8_SB(b, h) + boff + n * 2048 + k * 1024); } while (0)
#define PG8_MMA(ai, bj, At, Bt) do { __builtin_amdgcn_s_setprio(1); _Pragma("unroll") for (int m = 0; m < 4; ++m) _Pragma("unroll") for (int n = 0; n < 2; ++n) _Pragma("unroll") for (int k = 0; k < 2; ++k) \
        acc[ai][bj][m][n] = __builtin_amdgcn_mfma_f32_16x16x32_bf16(Bt[n][k], At[m][k], acc[ai][bj][m][n], 0, 0, 0); __builtin_amdgcn_s_setprio(0); } while (0)
#define PG8_WAIT_V(n) asm volatile("s_waitcnt vmcnt(" #n ")" ::: "memory")
#define PG8_WAIT_L(n) asm volatile("s_waitcnt lgkmcnt(" #n ")" ::: "memory")
#define PG8_BAR __builtin_amdgcn_s_barrier()
#define PG8_SCHED __builtin_amdgcn_sched_barrier(0)
    Unit cur, nxt; int ui = 0;
    if (!S.next(0, cur)) return;
    f32x4 acc[2][2][4][2];
#pragma unroll
    for (int a = 0; a < 2; ++a)
#pragma unroll
        for (int b = 0; b < 2; ++b)
#pragma unroll
            for (int m = 0; m < 4; ++m)
#pragma unroll
                for (int n = 0; n < 2; ++n) acc[a][b][m][n] = (f32x4){0.f, 0.f, 0.f, 0.f};
    bf16x8 At[4][2], B0[2][2], B1[2][2];
    const char* cA = (const char*)g.A + (size_t)cur.pm * tstep + (size_t)cur.k0t * kstep; const char* cB = (const char*)g.Bt + (size_t)cur.pn * tstep + (size_t)cur.k0t * kstep;
    S.a_ready(cur);
    PG8_STAGE(PG8_SB(0, 0), cB, voffB); PG8_STAGE(PG8_SA(0, 0), cA, voffA); PG8_STAGE(PG8_SB(0, 1), cB + hstep, voffB); PG8_STAGE(PG8_SA(0, 1), cA + hstep, voffA);
    if (wr == 1) PG8_BAR;
    PG8_WAIT_V(4); PG8_BAR;
    PG8_STAGE(PG8_SB(1, 0), cB + kstep, voffB); PG8_STAGE(PG8_SA(1, 0), cA + kstep, voffA); PG8_STAGE(PG8_SB(1, 1), cB + hstep + kstep, voffB);
    PG8_WAIT_V(6); PG8_BAR;
    PG8_STAMP();
    for (;;) {
        const bool has_next = S.next(ui + 1, nxt);
        const char* nA = has_next ? (const char*)g.A + (size_t)nxt.pm * tstep + (size_t)nxt.k0t * kstep : cA; const char* nB = has_next ? (const char*)g.Bt + (size_t)nxt.pn * tstep + (size_t)nxt.k0t * kstep : cB;
        const int cnt = cur.ntu ? cur.ntu : nt;
        for (int t = 0; t < cnt; t += 2) {
            const bool last = (t == cnt - 2);
            const char* a1 = cA + (size_t)(t + 1) * kstep;
            const char* a2 = last ? nA : cA + (size_t)(t + 2) * kstep; const char* b2 = last ? nB : cB + (size_t)(t + 2) * kstep;
            const char* a3 = a2 + kstep; const char* b3 = b2 + kstep;
            if (last && has_next) S.a_ready(nxt);
            PG8_LDB(B0, 0, 0); PG8_SCHED; PG8_LDA(At, 0, 0); PG8_STAGE(PG8_SA(1, 1), a1 + hstep, voffA);
            PG8_WAIT_L(8); PG8_BAR; PG8_WAIT_L(0); PG8_MMA(0, 0, At, B0); PG8_BAR; PG8_SCHED;
            PG8_LDB(B1, 0, 1); PG8_STAGE(PG8_SB(0, 0), b2, voffB);
            PG8_BAR; PG8_WAIT_L(0); PG8_MMA(0, 1, At, B1); PG8_BAR;
            PG8_LDA(At, 0, 1); PG8_STAGE(PG8_SA(0, 0), a2, voffA);
            PG8_BAR; PG8_WAIT_L(0); PG8_MMA(1, 0, At, B0); PG8_BAR; PG8_SCHED;
            PG8_STAGE(PG8_SB(0, 1), b2 + hstep, voffB);
            PG8_WAIT_V(6); PG8_BAR; PG8_MMA(1, 1, At, B1); PG8_BAR;
            PG8_LDB(B0, 1, 0); PG8_SCHED; PG8_LDA(At, 1, 0); PG8_STAGE(PG8_SA(0, 1), a2 + hstep, voffA);
            PG8_WAIT_L(8); PG8_BAR; PG8_WAIT_L(0); PG8_MMA(0, 0, At, B0); PG8_BAR; PG8_SCHED;
            PG8_LDB(B1, 1, 1); PG8_STAGE(PG8_SB(1, 0), b3, voffB);
            PG8_BAR; PG8_WAIT_L(0); PG8_MMA(0, 1, At, B1); PG8_BAR;
            PG8_LDA(At, 1, 1); PG8_STAGE(PG8_SA(1, 0), a3, voffA);
            PG8_BAR; PG8_WAIT_L(0); PG8_MMA(1, 0, At, B0); PG8_BAR; PG8_SCHED;
            PG8_STAGE(PG8_SB(1, 1), b3 + hstep, voffB);
            PG8_WAIT_V(6); PG8_BAR; PG8_MMA(1, 1, At, B1); PG8_BAR;
        }
        PG8_STAMP();
        if constexpr (!Epi::AFTER_DRAIN) { E(acc, cur, wr, wc, fr, fq); S.done(cur); }
        PG8_STAMP();
        if (!has_next) break;
#pragma unroll
        for (int a = 0; a < 2; ++a)
#pragma unroll
            for (int b = 0; b < 2; ++b)
#pragma unroll
                for (int m = 0; m < 4; ++m)
#pragma unroll
                    for (int n = 0; n < 2; ++n) acc[a][b][m][n] = (f32x4){0.f, 0.f, 0.f, 0.f};
        cur = nxt; cA = nA; cB = nB; ++ui;
    }
    PG8_WAIT_V(0);
    if (wr == 0) PG8_BAR;
    PG8_BAR;
    if constexpr (Epi::AFTER_DRAIN) { E.fused(acc, cur, wr, wc, fr, fq, lds, wid, lane); S.done(cur); }
    PG8_STAMP();
    if (STAMP && wid == 0) { stamps[lane] = lane < nts ? (((unsigned long long)(unsigned)ts_hi << 32) | (unsigned)ts_lo) : 0ull;
        if (lane == 62) stamps[62] = rt_entry; if (lane == 63) stamps[63] = (unsigned long long)wall_clock64(); }
#undef PG8_STAMP
#undef PG8_SA
#undef PG8_SB
#undef PG8_STAGE
#undef PG8_LDA
#undef PG8_LDB
#undef PG8_MMA
#undef PG8_WAIT_V
#undef PG8_WAIT_L
#undef PG8_BAR
#undef PG8_SCHED
}
}

namespace mk {
using pg8::bf16_t; using pg8::bf16x8; using pg8::f32x4; using pg8::u32x4;
typedef unsigned u32x2 __attribute__((ext_vector_type(2)));

constexpr int D = 1024, NB = 16, SEQ = 2048, CTXL = 256, NLAT = NB * SEQ, NCTX = NB * CTXL, T = NLAT + NCTX, DFF = 2816;
constexpr int NMOD = 9 * 1024;
constexpr float EPS = 1e-6f;
constexpr int LDS_BYTES = 131072 + 1024;
constexpr int NPHASE = 19;

constexpr size_t MiB = (size_t)1 << 20;
constexpr size_t WS_BT = 0, WS_HCTX = 48 * MiB, WS_XN = 64 * MiB, WS_SMALL = 136 * MiB, WS_BIG = 144 * MiB, WS_END = 504 * MiB;
constexpr size_t BT_W13A = 0, BT_W2A = 5767168, BT_MIXIN = 8650752, BT_MIXOUT = 13893632, BT_W13B = 14942208, BT_W2B = 20709376;
constexpr size_t SM_MOD = 0  , SM_LB = 2 * 17 * 9216  ;
constexpr size_t SM_GAM = SM_LB + 2048;
constexpr size_t SM_BIAS_UPA = SM_GAM + 6 * 17 * 1024;
constexpr size_t SM_BIAS_MIX = SM_BIAS_UPA + 17 * 5632;
constexpr size_t SM_BIAS_UPB = SM_BIAS_MIX + 17 * 5120;
constexpr size_t SM_RSS = SM_BIAS_UPB + 17 * 5632;
constexpr size_t WS_XN2 = WS_BIG + 200 * MiB;
constexpr size_t WS_BAR = WS_SMALL + 7 * MiB;
constexpr size_t AB_Q = 0, AB_K = (size_t)T * 512, AB_VTL = 2 * (size_t)T * 512, AB_VTC = AB_VTL + (size_t)NB * 512 * SEQ, AB_U = AB_VTC + (size_t)NB * 512 * CTXL;
constexpr size_t PLANE = (size_t)T * 1024;

struct Params { const float* in[19]; float* out; unsigned char* ws; int ph_lo, ph_hi; };

__device__ __forceinline__ unsigned pk2(float lo, float hi) { unsigned r; asm("v_cvt_pk_bf16_f32 %0, %1, %2" : "=v"(r) : "v"(lo), "v"(hi)); return r; }
__device__ __forceinline__ bf16_t f2bf(float x) { unsigned u = __float_as_uint(x); u += 0x7fffu + ((u >> 16) & 1u); return (bf16_t)(u >> 16); }
__device__ __forceinline__ float bflo(unsigned v) { return __uint_as_float(v << 16); }
__device__ __forceinline__ float bfhi(unsigned v) { return __uint_as_float(v & 0xffff0000u); }
__device__ __forceinline__ float bf2f(bf16_t v) { return __uint_as_float((unsigned)v << 16); }
__device__ __forceinline__ float silu_f(float a) { return a * __builtin_amdgcn_rcpf(1.0f + __expf(-a)); }
__device__ __forceinline__ bf16x8 mkfrag(unsigned a, unsigned b, unsigned c, unsigned d) { u32x4 w = {a, b, c, d}; return __builtin_bit_cast(bf16x8, w); }
#define MFMA16(a, b, c) __builtin_amdgcn_mfma_f32_16x16x32_bf16((a), (b), (c), 0, 0, 0)

struct NormFix { const float* rss; const float* bias; int N; };
__device__ __forceinline__ void load_rowscale(const NormFix& nf, const pg8::Unit& u, int wr, int fr, int fq, float (&r)[2][4]) {
#pragma unroll
    for (int ai = 0; ai < 2; ++ai)
#pragma unroll
        for (int m = 0; m < 4; ++m) {
            const int row = u.pm * 256 + ai * 128 + wr * 64 + m * 16 + fr;
            const f32x4 p = *(const f32x4*)(nf.rss + (size_t)row * 16 + 4 * fq);
            float s = (p[0] + p[1]) + (p[2] + p[3]);
            s += __shfl_xor(s, 16); s += __shfl_xor(s, 32);
            r[ai][m] = rsqrtf(s * (1.0f / 1024.0f) + EPS);
        }
}
__device__ __forceinline__ void load_bias(const NormFix& nf, const pg8::Unit& u, int wc, int fq, f32x4 (&bv)[2][2]) {
    const int row0 = u.pm * 256; const int j = row0 < NLAT ? (row0 >> 11) : 16;
    const float* bp = nf.bias + (size_t)j * nf.N + u.pn * 256 + wc * 32 + 4 * fq;
#pragma unroll
    for (int bj = 0; bj < 2; ++bj)
#pragma unroll
        for (int n = 0; n < 2; ++n) bv[bj][n] = *(const f32x4*)(bp + bj * 128 + n * 16);
}
struct EpiSwiGLU {
    static constexpr bool PERM = false, AFTER_DRAIN = false;
    bf16_t* act; NormFix nf;
    __device__ __forceinline__ void operator()(const f32x4 (&acc)[2][2][4][2], const pg8::Unit& u, int wr, int wc, int fr, int fq) const {
        const int row0 = u.pm * 256 + wr * 64 + fr;
        float r[2][4]; f32x4 bv[2][2]; load_rowscale(nf, u, wr, fr, fq, r); load_bias(nf, u, wc, fq, bv);
#pragma unroll
        for (int ai = 0; ai < 2; ++ai)
#pragma unroll
            for (int m = 0; m < 4; ++m) {
                bf16_t* rowp = act + (size_t)(row0 + ai * 128 + m * 16) * DFF + 4 * fq;
#pragma unroll
                for (int bj = 0; bj < 2; ++bj) {
                    const int g32 = 8 * u.pn + 4 * bj + wc;
                    const f32x4 a = acc[ai][bj][m][0] * r[ai][m] + bv[bj][0], b = acc[ai][bj][m][1] * r[ai][m] + bv[bj][1];
                    u32x2 w; w.x = pk2(silu_f(a[0]) * b[0], silu_f(a[1]) * b[1]); w.y = pk2(silu_f(a[2]) * b[2], silu_f(a[3]) * b[3]);
                    *(u32x2*)(rowp + 16 * g32) = w;
                }
            }
    }
};
template <bool EMIT>
struct EpiRes {
    static constexpr bool PERM = false, AFTER_DRAIN = false;
    const float* base_l; const float* base_c; float* out_l; float* out_c; const float* gate;
    const float* gam; bf16_t* xo; float* rss; float* parts; float coef; int wid;
    __device__ __forceinline__ void operator()(const f32x4 (&acc)[2][2][4][2], const pg8::Unit& u, int wr, int wc, int fr_, int fq_) const {
        const int lane_ = mk_tid(wid) & 63; const int fr = lane_ & 15, fq = lane_ >> 4;
        const int row0 = u.pm * 256; const bool lat = row0 < NLAT; const int j = lat ? (row0 >> 11) : 16;
        const float* bp = lat ? base_l + (size_t)row0 * D : base_c + (size_t)(row0 - NLAT) * D;
        float* op = lat ? out_l + (size_t)row0 * D : out_c + (size_t)(row0 - NLAT) * D;
        const int col0 = u.pn * 256 + wc * 32 + 4 * fq;
        const float* gp = gate + (size_t)j * NMOD + col0;
        if (u.split) {
            float* pp = parts + ((size_t)(u.split - 1) * NCTX + (size_t)(row0 - NLAT)) * D;
#pragma unroll
            for (int bj = 0; bj < 2; ++bj)
#pragma unroll
                for (int n = 0; n < 2; ++n) {
                    const f32x4 gq = *(const f32x4*)(gp + bj * 128 + n * 16) * coef;
#pragma unroll
                    for (int gi = 0; gi < 8; ++gi)
                        *(f32x4*)(pp + (size_t)(wr * 64 + fr + (gi >> 2) * 128 + (gi & 3) * 16) * D + col0 + bj * 128 + n * 16) = gq * acc[gi >> 2][bj][gi & 3][n];
                }
            return;
        }
        f32x4 gv[2][2], gm[2][2];
#pragma unroll
        for (int bj = 0; bj < 2; ++bj)
#pragma unroll
            for (int n = 0; n < 2; ++n) {
                gv[bj][n] = *(const f32x4*)(gp + bj * 128 + n * 16) * coef;
                if (EMIT) gm[bj][n] = *(const f32x4*)(gam + (size_t)j * 1024 + col0 + bj * 128 + n * 16);
            }
        f32x4 bs[2][2], bn[2][2];
        {
            const size_t off = (size_t)(wr * 64 + fr) * D + col0;
#pragma unroll
            for (int bj = 0; bj < 2; ++bj)
#pragma unroll
                for (int n = 0; n < 2; ++n) bn[bj][n] = *(const f32x4*)(bp + off + bj * 128 + n * 16);
        }
#pragma unroll
        for (int gi = 0; gi < 8; ++gi) {
            const int ai = gi >> 2, m = gi & 3;
            const int rl = wr * 64 + fr + ai * 128 + m * 16;
            const size_t off = (size_t)rl * D + col0;
#pragma unroll
            for (int bj = 0; bj < 2; ++bj)
#pragma unroll
                for (int n = 0; n < 2; ++n) bs[bj][n] = bn[bj][n];
            if (gi + 1 < 8) {
                const int rl2 = wr * 64 + fr + ((gi + 1) >> 2) * 128 + ((gi + 1) & 3) * 16;
                const size_t off2 = (size_t)rl2 * D + col0;
#pragma unroll
                for (int bj = 0; bj < 2; ++bj)
#pragma unroll
                    for (int n = 0; n < 2; ++n) bn[bj][n] = *(const f32x4*)(bp + off2 + bj * 128 + n * 16);
            }
            float ssq = 0.f;
#pragma unroll
            for (int bj = 0; bj < 2; ++bj)
#pragma unroll
                for (int n = 0; n < 2; ++n) {
                    const f32x4 hv = bs[bj][n] + gv[bj][n] * acc[ai][bj][m][n];
                    *(f32x4*)(op + off + bj * 128 + n * 16) = hv;
                    if (EMIT) {
                        ssq += (hv[0] * hv[0] + hv[1] * hv[1]) + (hv[2] * hv[2] + hv[3] * hv[3]);
                        const f32x4 a = hv * gm[bj][n];
                        u32x2 w; w.x = pk2(a[0], a[1]); w.y = pk2(a[2], a[3]);
                        *(u32x2*)(xo + (size_t)(row0 + rl) * D + col0 + bj * 128 + n * 16) = w;
                    }
                }
            if (EMIT) {
                ssq += __shfl_xor(ssq, 16); ssq += __shfl_xor(ssq, 32);
                if (fq == 0) rss[(size_t)(row0 + rl) * 16 + u.pn * 4 + wc] = ssq;
            }
        }
    }
};
struct EpiAB {
    static constexpr bool PERM = false, AFTER_DRAIN = false;
    bf16_t* big; NormFix nf;
    __device__ __forceinline__ void operator()(const f32x4 (&acc)[2][2][4][2], const pg8::Unit& u, int wr, int wc, int fr, int fq) const {
        const int sect = u.pn >> 1; const int row0 = u.pm * 256 + wr * 64 + fr; const int colbase = (u.pn & 1) * 256 + wc * 32 + 4 * fq;
        float r[2][4]; f32x4 bv[2][2]; load_rowscale(nf, u, wr, fr, fq, r); load_bias(nf, u, wc, fq, bv);
        if (sect != 2) {
            bf16_t* dst = big + (sect == 0 ? AB_Q : (sect == 1 ? AB_K : AB_U)); const float sc = sect == 0 ? 0.125f : 1.0f;
#pragma unroll
            for (int ai = 0; ai < 2; ++ai)
#pragma unroll
                for (int m = 0; m < 4; ++m) {
                    bf16_t* rowp = dst + (size_t)(row0 + ai * 128 + m * 16) * 512 + colbase;
#pragma unroll
                    for (int bj = 0; bj < 2; ++bj)
#pragma unroll
                        for (int n = 0; n < 2; ++n) { const f32x4 v = (acc[ai][bj][m][n] * r[ai][m] + bv[bj][n]) * sc; u32x2 w; w.x = pk2(v[0], v[1]); w.y = pk2(v[2], v[3]); *(u32x2*)(rowp + bj * 128 + n * 16) = w; }
                }
        } else {
            const bool lat = u.pm * 256 < NLAT;
#pragma unroll
            for (int ai = 0; ai < 2; ++ai)
#pragma unroll
                for (int m = 0; m < 4; ++m) {
                    const int row = row0 + ai * 128 + m * 16;
                    bf16_t* bp; size_t sd;
                    if (lat) { const int b = row >> 11, tok = row & 2047; bp = big + AB_VTL + ((size_t)b * 512 + colbase) * SEQ + tok; sd = SEQ; }
                    else { const int rc = row - NLAT; const int b = rc >> 8, tok = rc & 255; bp = big + AB_VTC + ((size_t)b * 512 + colbase) * CTXL + tok; sd = CTXL; }
#pragma unroll
                    for (int bj = 0; bj < 2; ++bj)
#pragma unroll
                        for (int n = 0; n < 2; ++n)
#pragma unroll
                            for (int j = 0; j < 4; ++j) bp[(size_t)(bj * 128 + n * 16 + j) * sd] = f2bf(acc[ai][bj][m][n][j] * r[ai][m] + bv[bj][n][j]);
                }
        }
    }
};
struct EpiHG {
    static constexpr bool PERM = false, AFTER_DRAIN = false;
    bf16_t* planes; NormFix nf; const float* lbv;
    __device__ __forceinline__ void operator()(const f32x4 (&acc)[2][2][4][2], const pg8::Unit& u, int wr, int wc, int fr, int fq) const {
        float r[2][4]; f32x4 bv[2][2]; load_rowscale(nf, u, wr, fr, fq, r); load_bias(nf, u, wc, fq, bv);
        const int plane = u.pn >> 2;
        const bool gate = (plane == 2) || (plane == 3);
        f32x4 oml[2][2];
        if (gate) {
#pragma unroll
            for (int bj = 0; bj < 2; ++bj)
#pragma unroll
                for (int n = 0; n < 2; ++n) oml[bj][n] = 1.0f - *(const f32x4*)(lbv + (plane - 2) * 1024 + (u.pn & 3) * 256 + wc * 32 + 4 * fq + bj * 128 + n * 16);
        } const int row0 = u.pm * 256 + wr * 64 + fr; const int colbase = (u.pn & 3) * 256 + wc * 32 + 4 * fq;
        bf16_t* dst = planes + (size_t)plane * PLANE; const bool act = (plane == 0) || (plane == 4);
#pragma unroll
        for (int ai = 0; ai < 2; ++ai)
#pragma unroll
            for (int m = 0; m < 4; ++m) {
                bf16_t* rowp = dst + (size_t)(row0 + ai * 128 + m * 16) * 1024 + colbase;
#pragma unroll
                for (int bj = 0; bj < 2; ++bj)
#pragma unroll
                    for (int n = 0; n < 2; ++n) {
                        f32x4 v = acc[ai][bj][m][n] * r[ai][m] + bv[bj][n];
                        if (act) { v[0] = silu_f(v[0]); v[1] = silu_f(v[1]); v[2] = silu_f(v[2]); v[3] = silu_f(v[3]); }
                        if (gate) {
#pragma unroll
                            for (int e = 0; e < 4; ++e) v[e] = oml[bj][n][e] * __builtin_amdgcn_rcpf(1.0f + __expf(v[e]));
                        }
                        u32x2 w; w.x = pk2(v[0], v[1]); w.y = pk2(v[2], v[3]); *(u32x2*)(rowp + bj * 128 + n * 16) = w;
                    }
            }
    }
};

struct PrefOrder : pg8::StaticOrder {
    const float* base_l; const float* base_c; PG8_LAS unsigned* sink; int wid;
    __device__ __forceinline__ void a_ready(const pg8::Unit& u) const {
        const int tid = mk_tid(wid);
        const int row0 = u.pm * 256; const float* bp = row0 < NLAT ? base_l + (size_t)row0 * D : base_c + (size_t)(row0 - NLAT) * D;
        bp += u.pn * 256;
#pragma unroll
        for (int i = 0; i < 4; ++i) { const int id = tid + 512 * i; __builtin_amdgcn_global_load_lds((const unsigned*)(bp + (size_t)(id >> 3) * D + (id & 7) * 32), sink, 4, 0, 0); }
    }
};
template <class Epi> __device__ __forceinline__ void run_gemm_res(PG8_LAS unsigned char* lds, const bf16_t* A, const bf16_t* Bt, int M, int N, int K, const Epi E, const int mk_wid) {
    pg8::Gemm g{A, Bt, M, N, K}; PrefOrder S; S.init(M, N, (int)gridDim.x, (int)blockIdx.x);
    S.base_l = E.base_l; S.base_c = E.base_c; S.sink = (PG8_LAS unsigned*)(lds + 131072); S.wid = mk_wid;
    pg8::gemm_phase<Epi, PrefOrder, false>(lds, g, S, E, nullptr, mk_wid);
}
struct SplitOrder {
    pg8::StaticOrder lat; int G, c, ntf;
    __device__ __forceinline__ void init(int N, int K, int G_, int c_) { lat.init(NLAT, N, G_, c_); G = G_; c = c_; ntf = K / 64; }
    __device__ __forceinline__ bool next(int i, pg8::Unit& u) const {
        const long L = (long)i * G + c;
        int pm = 0, pn = 0, k0t = 0, ntu = 0, split = 0; bool ok = true;
        if (L < lat.nwg) { pg8::Unit t; ok = lat.next(i, t); pm = t.pm; pn = t.pn; }
        else {
            const int idx = (int)(L - lat.nwg); ok = idx < 64 * 4;
            const int tile = idx >> 2, part = idx & 3;
            pm = 128 + (tile >> 2); pn = tile & 3; split = 1 + part;
            const int q = ntf >> 2, odd = q & 1, po = part & 1;
            k0t = q * part + (odd & po); ntu = q + odd * (1 - 2 * po);
        }
        u.pm = pm; u.pn = pn; u.k0t = k0t; u.ntu = ntu; u.split = split;
        return ok;
    }
    __device__ __forceinline__ void a_ready(const pg8::Unit&) const {}
    __device__ __forceinline__ void done(const pg8::Unit&) const {}
};
template <class Epi> __device__ __forceinline__ void run_gemm_split(PG8_LAS unsigned char* lds, const bf16_t* A, const bf16_t* Bt, int N, int K, const Epi E, const int mk_wid) {
    pg8::Gemm g{A, Bt, T, N, K}; SplitOrder S; S.init(N, K, (int)gridDim.x, (int)blockIdx.x);
    pg8::gemm_phase<Epi, SplitOrder, false>(lds, g, S, E, nullptr, mk_wid);
}
struct HgOrder {
    pg8::StaticOrder lat; int G, c;
    __device__ __forceinline__ void init(int G_, int c_) { lat.init(NLAT, 5120, G_, c_); G = G_; c = c_; }
    __device__ __forceinline__ bool next(int i, pg8::Unit& u) const {
        const long L = (long)i * G + c;
        int pm = 0, pn = 0; bool ok = true;
        if (L < lat.nwg) { pg8::Unit t; ok = lat.next(i, t); pm = t.pm; pn = t.pn; }
        else { const int idx = (int)(L - lat.nwg); ok = idx < 16 * 12; pm = 128 + idx / 12; pn = 4 + idx % 12; }
        u.pm = pm; u.pn = pn; u.k0t = 0; u.ntu = 0; u.split = 0;
        return ok;
    }
    __device__ __forceinline__ void a_ready(const pg8::Unit&) const {}
    __device__ __forceinline__ void done(const pg8::Unit&) const {}
};
template <class Epi> __device__ __forceinline__ void run_gemm_hg(PG8_LAS unsigned char* lds, const bf16_t* A, const bf16_t* Bt, const Epi E, const int mk_wid) {
    pg8::Gemm g{A, Bt, T, 5120, D}; HgOrder S; S.init((int)gridDim.x, (int)blockIdx.x);
    pg8::gemm_phase<Epi, HgOrder, false>(lds, g, S, E, nullptr, mk_wid);
}
template <class Epi> __device__ __forceinline__ void run_gemm(PG8_LAS unsigned char* lds, const bf16_t* A, const bf16_t* Bt, int M, int N, int K, const Epi E, const int mk_wid) {
    pg8::Gemm g{A, Bt, M, N, K}; pg8::StaticOrder S; S.init(M, N, (int)gridDim.x, (int)blockIdx.x);
    pg8::gemm_phase<Epi, pg8::StaticOrder, false>(lds, g, S, E, nullptr, mk_wid);
}

struct ConvJob { const float* src; bf16_t* dst; int ld, dstld, K, N, mode; };
__device__ __forceinline__ void conv_tile(unsigned char* lds, const ConvJob jb, int tile, const int mk_wid) {
    float* tl = (float*)lds;
    const int tid = mk_tid(mk_wid); const int ktiles = jb.K >> 8; const int rt = tile / ktiles, kt = tile - rt * ktiles; const int r0 = rt * 64, k0 = kt * 256;
    {
        const int r = tid & 63, kk = tid >> 6; const int rho = r0 + r; int col = rho;
        if (jb.mode == 1) col = ((rho >> 4) & 1) * DFF + 16 * (rho >> 5) + (rho & 15);
        const float* sp = jb.src + (size_t)(k0 + kk) * jb.ld + col;
        float v[32];
#pragma unroll
        for (int i = 0; i < 32; ++i) { v[i] = *sp; sp += (size_t)8 * jb.ld; }
#pragma unroll
        for (int i = 0; i < 32; ++i) tl[(kk + 8 * i) * 65 + r] = v[i];
    }
    __syncthreads();
#pragma unroll
    for (int i = 0; i < 4; ++i) {
        const int q = tid + 512 * i; const int r = ((q >> 6) & 7) * 8 + (q & 7), ks = (q >> 9) * 8 + ((q >> 3) & 7); float v[8];
#pragma unroll
        for (int e = 0; e < 8; ++e) v[e] = tl[(ks * 8 + e) * 65 + r];
        u32x4 w; w.x = pk2(v[0], v[1]); w.y = pk2(v[2], v[3]); w.z = pk2(v[4], v[5]); w.w = pk2(v[6], v[7]);
        *(u32x4*)(jb.dst + (size_t)(r0 + r) * jb.dstld + k0 + ks * 8) = w;
    }
    __syncthreads();
}
__device__ __forceinline__ void prep_weights(unsigned char* lds, const Params& P, int layer, const int mk_wid, int t_lo = 0, int t_hi = 1 << 30, int wg0 = 0) {
    bf16_t* bt = (bf16_t*)(P.ws + WS_BT);
    const float* w13 = P.in[7]; const float* w2 = P.in[8];
    const int b1 = 352, b2 = 528, b3 = layer == 0 ? 656 : 848, b4 = layer == 0 ? 688 : 912, b5 = b4 + 352, b6 = b5 + 176;
    if ((int)blockIdx.x < wg0) return;
    const int t_end = t_hi < b6 ? t_hi : b6;
    for (int t = t_lo + (int)blockIdx.x - wg0; t < t_end; t += (int)gridDim.x - wg0) {
        ConvJob jb; int tile;
        if (t < b1) { jb.src = w13 + (size_t)(layer * 2 + 0) * 1024 * 5632; jb.dst = bt + BT_W13A; jb.ld = 5632; jb.dstld = 1024; jb.K = 1024; jb.N = 5632; jb.mode = 1; tile = t; }
        else if (t < b2) { jb.src = w2 + (size_t)(layer * 2 + 0) * 2816 * 1024; jb.dst = bt + BT_W2A; jb.ld = 1024; jb.dstld = 2816; jb.K = 2816; jb.N = 1024; jb.mode = 0; tile = t - b1; }
        else if (t < b3) {
            if (layer == 0) { jb.src = P.in[9]; jb.ld = 2048; jb.N = 2048; } else { jb.src = P.in[14]; jb.ld = 5120; jb.N = 5120; }
            jb.dst = bt + BT_MIXIN; jb.dstld = 1024; jb.K = 1024; jb.mode = 0; tile = t - b2; }
        else if (t < b4) {
            if (layer == 0) { jb.src = P.in[13]; jb.K = 512; } else { jb.src = P.in[17]; jb.K = 1024; }
            jb.dst = bt + BT_MIXOUT; jb.ld = 1024; jb.dstld = 1024; jb.N = 1024; jb.mode = 0; tile = t - b3; }
        else if (t < b5) { jb.src = w13 + (size_t)(layer * 2 + 1) * 1024 * 5632; jb.dst = bt + BT_W13B; jb.ld = 5632; jb.dstld = 1024; jb.K = 1024; jb.N = 5632; jb.mode = 1; tile = t - b4; }
        else { jb.src = w2 + (size_t)(layer * 2 + 1) * 2816 * 1024; jb.dst = bt + BT_W2B; jb.ld = 1024; jb.dstld = 2816; jb.K = 2816; jb.N = 1024; jb.mode = 0; tile = t - b5; }
        conv_tile(lds, jb, tile, mk_wid);
    }
}
__device__ __forceinline__ void pool_fold(unsigned char* lds, const Params& P, const int mk_wid) {
    float* As = (float*)lds;
    float* Bs = As + 128 * 132;
    bf16_t* bto = (bf16_t*)(P.ws + WS_BT) + BT_MIXOUT; const float* pw = P.in[11]; const float* ps = P.in[12]; const float* wo = P.in[13];
    const int tid = mk_tid(mk_wid);
    for (int item = blockIdx.x; item < 64; item += gridDim.x) {
        const int g = item >> 4, nb = item & 15;
        __syncthreads();
#pragma unroll
        for (int i = 0; i < 8; ++i) { const int idx = tid + 512 * i; const int c = idx >> 5, d4 = (idx & 31) * 4;
            const f32x4 a = *(const f32x4*)(pw + (size_t)(g * 128 + c) * 128 + d4), s = *(const f32x4*)(ps + g * 128 + d4); *(f32x4*)(As + c * 132 + d4) = a * s; }
#pragma unroll
        for (int i = 0; i < 4; ++i) { const int idx = tid + 512 * i; const int d = idx >> 4, n4 = (idx & 15) * 4;
            *(f32x4*)(Bs + d * 64 + n4) = *(const f32x4*)(wo + (size_t)(512 + g * 128 + d) * 1024 + nb * 64 + n4); }
        __syncthreads();
        const int n = tid & 63, cg = tid >> 6; float acc[16];
#pragma unroll
        for (int i = 0; i < 16; ++i) acc[i] = 0.f;
#pragma unroll 2
        for (int d = 0; d < 128; d += 4) {
            const float b0 = Bs[(d + 0) * 64 + n], b1 = Bs[(d + 1) * 64 + n], b2 = Bs[(d + 2) * 64 + n], b3 = Bs[(d + 3) * 64 + n];
#pragma unroll
            for (int i = 0; i < 16; ++i) { const f32x4 a = *(const f32x4*)(As + (cg * 16 + i) * 132 + d); acc[i] += a[0] * b0 + a[1] * b1 + a[2] * b2 + a[3] * b3; }
        }
        u32x4 w0, w1;
#pragma unroll
        for (int q = 0; q < 4; ++q) { w0[q] = pk2(acc[2 * q], acc[2 * q + 1]); w1[q] = pk2(acc[8 + 2 * q], acc[8 + 2 * q + 1]); }
        bf16_t* dp = bto + (size_t)(nb * 64 + n) * 1024 + 512 + g * 128 + cg * 16;
        *(u32x4*)dp = w0; *(u32x4*)(dp + 8) = w1;
    }
    __syncthreads();
}
__device__ __forceinline__ void gemv17_item(const float* sc, float* red, const float* wcol4  , size_t ld, float* outp  , size_t outld, const float* badd  , const int mk_wid) {
    const int tid = mk_tid(mk_wid), cl4 = tid & 15, kg = tid >> 4, wv = tid >> 6;
    const float* wp = wcol4 + (size_t)(kg * 32) * ld;
    f32x4 acc[17];
#pragma unroll
    for (int j = 0; j < 17; ++j) acc[j] = (f32x4){0.f, 0.f, 0.f, 0.f};
#pragma unroll 1
    for (int k = 0; k < 32; k += 8) {
        f32x4 w[8];
#pragma unroll
        for (int i = 0; i < 8; ++i) { w[i] = *(const f32x4*)wp; wp += ld; }
#pragma unroll
        for (int q = 0; q < 2; ++q) {
#pragma unroll
            for (int j = 0; j < 17; ++j) { const f32x4 s = *(const f32x4*)(sc + j * 1024 + kg * 32 + k + 4 * q); acc[j] += w[4 * q] * s[0] + w[4 * q + 1] * s[1] + w[4 * q + 2] * s[2] + w[4 * q + 3] * s[3]; }
            __builtin_amdgcn_sched_barrier(0);
        }
    }
#pragma unroll
    for (int j = 0; j < 17; ++j) {
#pragma unroll
        for (int e = 0; e < 4; ++e) { float v = acc[j][e]; v += __shfl_xor(v, 16); v += __shfl_xor(v, 32); acc[j][e] = v; }
        if ((tid & 63) < 16) *(f32x4*)(red + (wv * 17 + j) * 64 + 4 * cl4) = acc[j];
    }
    __syncthreads();
    for (int o = tid; o < 17 * 64; o += 512) {
        const int j = o >> 6, c2 = o & 63; float s = 0.f;
#pragma unroll
        for (int q = 0; q < 8; ++q) s += red[(q * 17 + j) * 64 + c2];
        outp[(size_t)j * outld + c2] = s + (badd ? badd[c2] : 0.f);
    }
    __syncthreads();
}
__device__ __forceinline__ void mod_phase(unsigned char* lds, const Params& P, const int mk_wid) {
    float* sc = (float*)lds;
    float* red = sc + 17 * 1024;
    const int tid = mk_tid(mk_wid); const float* c = P.in[1]; const float* cc = P.in[3]; const float* wm = P.in[4]; const float* bm = P.in[5];
    float* small = (float*)(P.ws + WS_SMALL);
    for (int i = blockIdx.x * 512 + tid; i < 2048; i += gridDim.x * 512) { const float l0 = P.in[15][i], l1 = P.in[15][2048 + i]; small[SM_LB + i] = 1.0f / (1.0f + __expf(l0 - l1)); }
    for (int idx = tid; idx < 17 * 1024; idx += 512) { const int j = idx >> 10, k = idx & 1023; const float v = j < 16 ? c[j * 1024 + k] : cc[k]; sc[idx] = v / (1.0f + __expf(-v)); }
    __syncthreads();
    for (int item = blockIdx.x; item < 288; item += gridDim.x) {
        const int l = item / 144, nb = item - l * 144;
        gemv17_item(sc, red, wm + (size_t)l * 1024 * NMOD + nb * 64 + 4 * (tid & 15), NMOD, small + SM_MOD + (size_t)l * 17 * NMOD + nb * 64, NMOD, bm + l * NMOD + nb * 64, mk_wid);
    }
}
__device__ __forceinline__ void bias_phase(unsigned char* lds, const Params& P, int layer, const int mk_wid, int wg0 = 0) {
    float* sc = (float*)lds; float* red = sc + 17 * 1024; const int tid = mk_tid(mk_wid);
    float* small = (float*)(P.ws + WS_SMALL); const float* modl = small + SM_MOD + (size_t)layer * 17 * NMOD;
    const int nmix = layer == 0 ? 32 : 80; const int nitems = 88 + nmix + 88;
    int staged = -1;
    for (int item = (int)blockIdx.x - wg0; item >= 0 && item < nitems; item += (int)gridDim.x - wg0) {
        const int which = item < 88 ? 0 : (item < 88 + nmix ? 1 : 2); const int nb = which == 0 ? item : (which == 1 ? item - 88 : item - 88 - nmix);
        if (staged != which) {
            __syncthreads();
            for (int idx = tid; idx < 17 * 1024; idx += 512) { const int j = idx >> 10, k = idx & 1023; sc[idx] = modl[(size_t)j * NMOD + (3 * which) * 1024 + k]; }
            __syncthreads(); staged = which;
        }
        const int rho = nb * 64 + 4 * (tid & 15);
        const float* wsrc; size_t ld; float* outp;
        if (which == 1) { ld = layer == 0 ? 2048 : 5120; wsrc = (layer == 0 ? P.in[9] : P.in[14]) + rho; outp = small + SM_BIAS_MIX + nb * 64; }
        else {
            ld = 5632; wsrc = P.in[7] + (size_t)(layer * 2 + (which == 2 ? 1 : 0)) * 1024 * 5632 + (((rho >> 4) & 1) * DFF + 16 * (rho >> 5) + (rho & 15));
            outp = small + (which == 0 ? SM_BIAS_UPA : SM_BIAS_UPB) + nb * 64;
        }
        gemv17_item(sc, red, wsrc, ld, outp, ld, nullptr, mk_wid);
    }
    if (layer == 0) {
        const float* ng = P.in[6];
        for (int i = blockIdx.x * 512 + tid; i < 6 * 17 * 1024; i += gridDim.x * 512) {
            const int s = i / (17 * 1024), rem = i - s * 17 * 1024, j = rem >> 10, c = rem & 1023, l = s / 3, k = s - 3 * l;
            small[SM_GAM + i] = ng[s * 1024 + c] * (1.0f + small[SM_MOD + ((size_t)l * 17 + j) * NMOD + (3 * k + 1) * 1024 + c]);
        }
    }
}

__device__ __forceinline__ float wave_sum(float v) {
#pragma unroll
    for (int o = 32; o >= 1; o >>= 1) v += __shfl_xor(v, o);
    return v;
}
__device__ __forceinline__ void prenorm_phase(const float* hl, const float* hc, const float* g, const float* modl, int sc_idx, bf16_t* xn, float* rss, int nrows, const int mk_wid) {
    const int lane = mk_tid(mk_wid) & 63; const int gw = blockIdx.x * 8 + (mk_tid(mk_wid) >> 6), nw = gridDim.x * 8;
    for (int row0 = 2 * gw; row0 < nrows; row0 += 2 * nw) {
        f32x4 v[2][4]; float ss[2];
#pragma unroll
        for (int rr = 0; rr < 2; ++rr) {
            const int row = row0 + rr; const bool lat = row < NLAT; const float* src = lat ? hl + (size_t)row * D : hc + (size_t)(row - NLAT) * D;
#pragma unroll
            for (int i = 0; i < 4; ++i) v[rr][i] = *(const f32x4*)(src + i * 256 + lane * 4);
        }
#pragma unroll
        for (int rr = 0; rr < 2; ++rr) {
            float s = 0.f;
#pragma unroll
            for (int i = 0; i < 4; ++i) s += v[rr][i][0] * v[rr][i][0] + v[rr][i][1] * v[rr][i][1] + v[rr][i][2] * v[rr][i][2] + v[rr][i][3] * v[rr][i][3];
            ss[rr] = wave_sum(s);
        }
#pragma unroll
        for (int rr = 0; rr < 2; ++rr) {
            const int row = row0 + rr; const int j = row < NLAT ? (row >> 11) : 16;
            const float* scp = modl + (size_t)j * NMOD + sc_idx * 1024;
            if (lane < 16) rss[(size_t)row * 16 + lane] = lane == 0 ? ss[rr] : 0.f;
#pragma unroll
            for (int i = 0; i < 4; ++i) {
                const int cidx = i * 256 + lane * 4;
                const f32x4 gg = *(const f32x4*)(g + cidx), s1 = *(const f32x4*)(scp + cidx);
                const f32x4 y = v[rr][i] * gg * (s1 + 1.0f);
                u32x2 w; w.x = pk2(y[0], y[1]); w.y = pk2(y[2], y[3]); *(u32x2*)(xn + (size_t)row * D + cidx) = w;
            }
        }
    }
}
__device__ __forceinline__ void ctx_emit_phase(const float* hsrc, float* hc, const float* parts, const float* gamc, bf16_t* xn, float* rss, const int mk_wid) {
    const int lane = mk_tid(mk_wid) & 63; const int gw = blockIdx.x * 8 + (mk_tid(mk_wid) >> 6), nw = gridDim.x * 8;
    for (int rc = gw; rc < NCTX; rc += nw) {
        const float* srcr = hsrc + (size_t)rc * D; float* src = hc + (size_t)rc * D; const int row = NLAT + rc;
        f32x4 v[4]; float ss = 0.f;
#pragma unroll
        for (int i = 0; i < 4; ++i) {
            const size_t o = (size_t)rc * D + i * 256 + lane * 4;
            v[i] = *(const f32x4*)(srcr + i * 256 + lane * 4) + ((*(const f32x4*)(parts + o) + *(const f32x4*)(parts + (size_t)NCTX * D + o)) + (*(const f32x4*)(parts + 2 * (size_t)NCTX * D + o) + *(const f32x4*)(parts + 3 * (size_t)NCTX * D + o)));
            ss += v[i][0] * v[i][0] + v[i][1] * v[i][1] + v[i][2] * v[i][2] + v[i][3] * v[i][3];
        }
        ss = wave_sum(ss);
        if (lane < 16) rss[(size_t)row * 16 + lane] = lane == 0 ? ss : 0.f;
#pragma unroll
        for (int i = 0; i < 4; ++i) {
            const int cidx = i * 256 + lane * 4;
            *(f32x4*)(src + cidx) = v[i];
            const f32x4 y = v[i] * *(const f32x4*)(gamc + cidx);
            u32x2 w; w.x = pk2(y[0], y[1]); w.y = pk2(y[2], y[3]); *(u32x2*)(xn + (size_t)row * D + cidx) = w;
        }
    }
}
__device__ __forceinline__ void final_norm_phase(float* h, const float* g, const int mk_wid) {
    const int lane = mk_tid(mk_wid) & 63; const int gw = blockIdx.x * 8 + (mk_tid(mk_wid) >> 6), nw = gridDim.x * 8;
    for (int row0 = 2 * gw; row0 < NLAT; row0 += 2 * nw) {
        f32x4 v[2][4]; float r[2];
#pragma unroll
        for (int rr = 0; rr < 2; ++rr)
#pragma unroll
            for (int i = 0; i < 4; ++i) v[rr][i] = *(const f32x4*)(h + (size_t)(row0 + rr) * D + i * 256 + lane * 4);
#pragma unroll
        for (int rr = 0; rr < 2; ++rr) {
            float s = 0.f;
#pragma unroll
            for (int i = 0; i < 4; ++i) s += v[rr][i][0] * v[rr][i][0] + v[rr][i][1] * v[rr][i][1] + v[rr][i][2] * v[rr][i][2] + v[rr][i][3] * v[rr][i][3];
            r[rr] = rsqrtf(wave_sum(s) * (1.0f / 1024.0f) + EPS);
        }
#pragma unroll
        for (int rr = 0; rr < 2; ++rr)
#pragma unroll
            for (int i = 0; i < 4; ++i) { const int cidx = i * 256 + lane * 4; const f32x4 gg = *(const f32x4*)(g + cidx); *(f32x4*)(h + (size_t)(row0 + rr) * D + cidx) = v[rr][i] * r[rr] * gg; }
    }
}
__device__ __forceinline__ void readout_phase(const bf16_t* planes, const float* gnorm, bf16_t* dst, const int mk_wid) {
    const int lane = mk_tid(mk_wid) & 63; const int gw = blockIdx.x * 8 + (mk_tid(mk_wid) >> 6), nw = gridDim.x * 8;
    const int c0 = lane * 16;
    float gn[16];
#pragma unroll
    for (int e = 0; e < 16; ++e) gn[e] = gnorm[(c0 + e) & 127];
    for (int row0 = 2 * gw; row0 < NLAT; row0 += 2 * nw) {
        u32x4 a0[2], a1[2], b0[2], b1[2], g0[2], g1[2];
#pragma unroll
        for (int rr = 0; rr < 2; ++rr) {
            const size_t off = (size_t)(row0 + rr) * 1024 + c0;
            a0[rr] = *(const u32x4*)(planes + 2 * PLANE + off); a1[rr] = *(const u32x4*)(planes + 2 * PLANE + off + 8);
            b0[rr] = *(const u32x4*)(planes + 3 * PLANE + off); b1[rr] = *(const u32x4*)(planes + 3 * PLANE + off + 8);
            g0[rr] = *(const u32x4*)(planes + 4 * PLANE + off); g1[rr] = *(const u32x4*)(planes + 4 * PLANE + off + 8);
        }
#pragma unroll
        for (int rr = 0; rr < 2; ++rr) {
            const size_t off = (size_t)(row0 + rr) * 1024 + c0;
            float o[16], sg[16]; float ss = 0.f;
#pragma unroll
            for (int q = 0; q < 4; ++q) {
                o[2 * q] = bflo(a0[rr][q]) + bflo(b0[rr][q]); o[2 * q + 1] = bfhi(a0[rr][q]) + bfhi(b0[rr][q]);
                o[8 + 2 * q] = bflo(a1[rr][q]) + bflo(b1[rr][q]); o[8 + 2 * q + 1] = bfhi(a1[rr][q]) + bfhi(b1[rr][q]);
                sg[2 * q] = bflo(g0[rr][q]); sg[2 * q + 1] = bfhi(g0[rr][q]); sg[8 + 2 * q] = bflo(g1[rr][q]); sg[8 + 2 * q + 1] = bfhi(g1[rr][q]);
            }
#pragma unroll
            for (int e = 0; e < 16; ++e) ss += o[e] * o[e];
            ss += __shfl_xor(ss, 1); ss += __shfl_xor(ss, 2); ss += __shfl_xor(ss, 4);
            const float r = rsqrtf(ss * (1.0f / 128.0f) + EPS);
            u32x4 w0, w1;
#pragma unroll
            for (int q = 0; q < 4; ++q) {
                w0[q] = pk2(o[2 * q] * r * gn[2 * q] * sg[2 * q], o[2 * q + 1] * r * gn[2 * q + 1] * sg[2 * q + 1]);
                w1[q] = pk2(o[8 + 2 * q] * r * gn[8 + 2 * q] * sg[8 + 2 * q], o[8 + 2 * q + 1] * r * gn[8 + 2 * q + 1] * sg[8 + 2 * q + 1]);
            }
            *(u32x4*)(dst + off) = w0; *(u32x4*)(dst + off + 8) = w1;
        }
    }
}

constexpr int KS_LD = 72, VS_LD = 264;
__device__ __forceinline__ void attn_softmax16(f32x4 (&s)[16], float& mx_out, float& sum_out) {
    float mx = -1e30f;
#pragma unroll
    for (int kt = 0; kt < 16; ++kt) mx = fmaxf(fmaxf(fmaxf(s[kt][0], s[kt][1]), fmaxf(s[kt][2], s[kt][3])), mx);
    mx = fmaxf(mx, __shfl_xor(mx, 16)); mx = fmaxf(mx, __shfl_xor(mx, 32));
    float sum = 0.f;
#pragma unroll
    for (int kt = 0; kt < 16; ++kt) {
#pragma unroll
        for (int j = 0; j < 4; ++j) { const float p = __expf(s[kt][j] - mx); s[kt][j] = p; sum += p; }
    }
    sum += __shfl_xor(sum, 16); sum += __shfl_xor(sum, 32);
    mx_out = mx; sum_out = sum;
}
__device__ __forceinline__ bf16x8 attn_pfrag(const f32x4 (&s)[16], int i) {
    return mkfrag(pk2(s[2 * i][0], s[2 * i][1]), pk2(s[2 * i][2], s[2 * i][3]), pk2(s[2 * i + 1][0], s[2 * i + 1][1]), pk2(s[2 * i + 1][2], s[2 * i + 1][3]));
}
__device__ __forceinline__ void attn_ctx_half(const bf16_t* Ks, const bf16_t* Vs, const bf16x8 (&qf)[2], int lane, float& mx_out, float& sum_out, f32x4 (&o)[4]) {
    const int l15 = lane & 15, g = lane >> 4;
    f32x4 s[16];
#pragma unroll
    for (int kt = 0; kt < 16; ++kt) {
        const bf16_t* kp = Ks + (16 * kt + l15) * KS_LD + 8 * g;
        const bf16x8 k0 = *(const bf16x8*)kp, k1 = *(const bf16x8*)(kp + 32);
        f32x4 a = {0.f, 0.f, 0.f, 0.f};
        a = MFMA16(k0, qf[0], a); a = MFMA16(k1, qf[1], a);
        s[kt] = a;
    }
    attn_softmax16(s, mx_out, sum_out);
#pragma unroll
    for (int mt = 0; mt < 4; ++mt) o[mt] = (f32x4){0.f, 0.f, 0.f, 0.f};
#pragma unroll
    for (int i = 0; i < 8; ++i) {
        const bf16x8 pb = attn_pfrag(s, i);
#pragma unroll
        for (int mt = 0; mt < 4; ++mt) {
            const bf16_t* vp = Vs + (16 * mt + l15) * VS_LD + 32 * i + 4 * g;
            const u32x2 lo = *(const u32x2*)vp, hi = *(const u32x2*)(vp + 16);
            o[mt] = MFMA16(mkfrag(lo.x, lo.y, hi.x, hi.y), pb, o[mt]);
        }
    }
}
__device__ __forceinline__ void attn_ctx_tile(const bf16_t* big, bf16_t* cat, const bf16_t* Ks, const bf16_t* Vs, int b, int h, int qt, int lane) {
    const int l15 = lane & 15, g = lane >> 4;
    const int qrow = NLAT + b * CTXL + 16 * qt + l15;
    bf16x8 qf[2];
#pragma unroll
    for (int ks = 0; ks < 2; ++ks) qf[ks] = *(const bf16x8*)(big + AB_Q + (size_t)qrow * 512 + h * 64 + 32 * ks + 8 * g);
    float m2, l2; f32x4 o[4];
    attn_ctx_half(Ks, Vs, qf, lane, m2, l2, o);
    const float inv = 1.0f / l2;
    bf16_t* op = cat + (size_t)qrow * 1024 + h * 64 + 4 * g;
#pragma unroll
    for (int mt = 0; mt < 4; ++mt) { u32x2 w; w.x = pk2(o[mt][0] * inv, o[mt][1] * inv); w.y = pk2(o[mt][2] * inv, o[mt][3] * inv); *(u32x2*)(op + 16 * mt) = w; }
}
__device__ __forceinline__ void attn_lat_tile(const bf16_t* big, bf16_t* cat, const bf16_t* Ks, const bf16_t* Vs, const float* rp, int b, int h, int r, int n, int lane) {
    const int l15 = lane & 15, g = lane >> 4;
    const int qrow = b * SEQ + r * 64 + 16 * n + l15;
    const int r0 = min(max(r - 4, 0), 24), band0 = min(max(16 * n - 8, 0), 32);
    bf16x8 qf[2];
#pragma unroll
    for (int ks = 0; ks < 2; ++ks) qf[ks] = *(const bf16x8*)(big + AB_Q + (size_t)qrow * 512 + h * 64 + 32 * ks + 8 * g);
    const bf16_t* kbase = big + AB_K + (size_t)(b * SEQ + r0 * 64 + band0 + l15) * 512 + h * 64 + 8 * g;
    bf16x8 kA[8], kB[8];
#define ATT_KLOAD(dst, k0) do { _Pragma("unroll") for (int kk = 0; kk < 4; ++kk) { const int kt_ = (k0) + kk; const bf16_t* kp = kbase + (size_t)((kt_ >> 1) * 64 + 16 * (kt_ & 1)) * 512; \
        dst[2 * kk] = *(const bf16x8*)kp; dst[2 * kk + 1] = *(const bf16x8*)(kp + 32); } } while (0)
#define ATT_QK(src, k0) do { _Pragma("unroll") for (int kk = 0; kk < 4; ++kk) { f32x4 a = {0.f, 0.f, 0.f, 0.f}; a = MFMA16(src[2 * kk], qf[0], a); a = MFMA16(src[2 * kk + 1], qf[1], a); s[(k0) + kk] = a; } } while (0)
    ATT_KLOAD(kA, 0);
    __builtin_amdgcn_sched_barrier(0);
    float m2, l2; f32x4 o2[4];
    attn_ctx_half(Ks, Vs, qf, lane, m2, l2, o2);
    __builtin_amdgcn_sched_barrier(0);
    ATT_KLOAD(kB, 4);
    __builtin_amdgcn_sched_barrier(0);
    f32x4 s[16];
    ATT_QK(kA, 0);
    ATT_KLOAD(kA, 8);
    __builtin_amdgcn_sched_barrier(0);
    ATT_QK(kB, 4);
    ATT_KLOAD(kB, 12);
    __builtin_amdgcn_sched_barrier(0);
    const bf16_t* vbase = big + AB_VTL + ((size_t)b * 512 + h * 64 + l15) * SEQ + r0 * 64 + band0 + 4 * g;
    u32x2 vG[4][8];
#define ATT_VLOAD(dst, i0) do { _Pragma("unroll") for (int mt = 0; mt < 4; ++mt) { \
        const bf16_t* vp = vbase + (size_t)(16 * mt) * SEQ + (i0) * 64; dst[mt * 2] = *(const u32x2*)vp; dst[mt * 2 + 1] = *(const u32x2*)(vp + 16); } } while (0)
#define ATT_PV(src, i0) do { const bf16x8 pb = attn_pfrag(s, (i0)); _Pragma("unroll") for (int mt = 0; mt < 4; ++mt) \
        o1[mt] = MFMA16(mkfrag(src[mt * 2].x, src[mt * 2].y, src[mt * 2 + 1].x, src[mt * 2 + 1].y), pb, o1[mt]); } while (0)
    ATT_QK(kA, 8);
    __builtin_amdgcn_sched_barrier(0);
    ATT_QK(kB, 12);
    __builtin_amdgcn_sched_barrier(0);
#pragma unroll
    for (int i = 0; i < 4; ++i) ATT_VLOAD(vG[i], i);
    __builtin_amdgcn_sched_barrier(0);
#undef ATT_KLOAD
#undef ATT_QK
    {
        const int cq = 16 * n + l15; const int wc0 = min(max(cq - 8, 0), 48);
#pragma unroll
        for (int kt = 0; kt < 16; ++kt) {
            const int rowi = r0 + (kt >> 1) - r + 7;
#pragma unroll
            for (int j = 0; j < 4; ++j) {
                const int kcol = band0 + 16 * (kt & 1) + 4 * g + j;
                const bool ok = (kcol >= wc0) && (kcol < wc0 + 16);
                const int rel = min(max(kcol - cq, -15), 15) + 15;
                const float bias = rp[rowi * 31 + rel];
                s[kt][j] = ok ? s[kt][j] + bias : -1e30f;
            }
        }
    }
    float m1, l1; attn_softmax16(s, m1, l1);
    f32x4 o1[4];
#pragma unroll
    for (int mt = 0; mt < 4; ++mt) o1[mt] = (f32x4){0.f, 0.f, 0.f, 0.f};
#pragma unroll
    for (int i = 0; i < 4; ++i) ATT_PV(vG[i], i);
    __builtin_amdgcn_sched_barrier(0);
#pragma unroll
    for (int i = 0; i < 4; ++i) ATT_VLOAD(vG[i], 4 + i);
    __builtin_amdgcn_sched_barrier(0);
#pragma unroll
    for (int i = 0; i < 4; ++i) ATT_PV(vG[i], 4 + i);
#undef ATT_VLOAD
#undef ATT_PV
    const float m = fmaxf(m1, m2); const float a1 = __expf(m1 - m), a2 = __expf(m2 - m);
    const float inv = 1.0f / (l2 * a2 + l1 * a1);
    bf16_t* op = cat + (size_t)qrow * 1024 + h * 64 + 4 * g;
#pragma unroll
    for (int mt = 0; mt < 4; ++mt) {
        const f32x4 ov = (o2[mt] * a2 + o1[mt] * a1) * inv;
        u32x2 w; w.x = pk2(ov[0], ov[1]); w.y = pk2(ov[2], ov[3]); *(u32x2*)(op + 16 * mt) = w;
    }
}
__device__ __forceinline__ void mixer_ab_phase(unsigned char* lds, const Params& P, const int mk_wid) {
    bf16_t* Ks = (bf16_t*)lds;
    bf16_t* Vs = Ks + 256 * KS_LD;
    float* rpbs = (float*)(Vs + 64 * VS_LD);
    const bf16_t* big = (const bf16_t*)(P.ws + WS_BIG); bf16_t* cat = (bf16_t*)(P.ws + WS_XN);
    const int tid = mk_tid(mk_wid), lane = tid & 63, w = tid >> 6;
    for (int item = blockIdx.x; item < 256; item += gridDim.x) {
        const int half = item & 1, h = (item >> 1) & 7, b = item >> 4;
        __syncthreads();
#pragma unroll
        for (int i = 0; i < 4; ++i) {
            const int q = tid + 512 * i;
            { const int row = q >> 3, part = q & 7; *(u32x4*)(Ks + row * KS_LD + part * 8) = *(const u32x4*)(big + AB_K + (size_t)(NLAT + b * CTXL + row) * 512 + h * 64 + part * 8); }
            { const int d = q >> 5, part = q & 31; *(u32x4*)(Vs + d * VS_LD + part * 8) = *(const u32x4*)(big + AB_VTC + ((size_t)b * 512 + h * 64 + d) * CTXL + part * 8); }
        }
        if (tid < 465) rpbs[tid] = P.in[10][h * 465 + tid];
        __syncthreads();
        for (int it = 0; it < 8; ++it) attn_lat_tile(big, cat, Ks, Vs, rpbs, b, h, half * 16 + 2 * it + (w >> 2), w & 3, lane);
        attn_ctx_tile(big, cat, Ks, Vs, b, h, half * 8 + w, lane);
    }
    __syncthreads();
    const bf16_t* U = big + AB_U;
    for (int idx = blockIdx.x * 512 + tid; idx < T * 64; idx += gridDim.x * 512) {
        const int row = idx >> 6, c8 = idx & 63, ch = c8 * 8, grp = c8 >> 4, wd = 2 << grp, hf = wd >> 1;
        int base, L, t;
        if (row < NLAT) { base = row & ~2047; L = SEQ; t = row & 2047; } else { const int rc = row - NLAT; base = NLAT + (rc & ~255); L = CTXL; t = rc & 255; }
        const int lo = max(t - hf, 0), hi = min(t - hf + wd, L);
        float acc[8];
#pragma unroll
        for (int e = 0; e < 8; ++e) acc[e] = 0.f;
#pragma unroll
        for (int i = 0; i < 16; ++i) {
            const int tt = lo + i;
            u32x4 v = {0u, 0u, 0u, 0u};
            if (tt < hi) v = *(const u32x4*)(U + (size_t)(base + tt) * 512 + ch);
#pragma unroll
            for (int q = 0; q < 4; ++q) { acc[2 * q] += bflo(v[q]); acc[2 * q + 1] += bfhi(v[q]); }
        }
        const u32x4 sv = *(const u32x4*)(U + (size_t)row * 512 + ch);
        const float invn = 1.0f / (float)(hi - lo);
        u32x4 w4;
#pragma unroll
        for (int q = 0; q < 4; ++q) w4[q] = pk2(acc[2 * q] * invn - bflo(sv[q]), acc[2 * q + 1] * invn - bfhi(sv[q]));
        *(u32x4*)(cat + (size_t)row * 1024 + 512 + ch) = w4;
    }
}

__device__ __forceinline__ void scan_phase(unsigned char* lds, const Params& P, const int mk_wid) {
    constexpr int RLD = 136, RT = 32 * RLD;
    bf16_t* Raw = (bf16_t*)lds;
    float* Pt = (float*)(lds + 2 * 3 * RT * 2);
    float* EG = Pt + 512;
    bf16_t* Qh = (bf16_t*)(EG + 128);
    bf16_t* Qt = Qh + RT;
    bf16_t* Kt = Qt + RT;
    bf16_t* KhT = Kt + RT;
    bf16_t* VT = KhT + 128 * 40;
    bf16_t* Am = VT + 128 * 40;
    bf16_t* Os = Am + 32 * 40;
    bf16_t* planes = (bf16_t*)(P.ws + WS_BIG);
    const int tid = mk_tid(mk_wid), lane = tid & 63, w = tid >> 6, g = lane >> 4, l15 = lane & 15;
    const int lp = tid >> 4, c8 = tid & 15;
    const int ch = tid & 127, pg = tid >> 7;
    for (int chain = blockIdx.x; chain < 256; chain += gridDim.x) {
        const int dir = chain & 1, h = (chain >> 1) & 7, b = chain >> 4;
        const int col = h * 128 + 8 * c8; const int sgn = dir ? -1 : 1;
        const bf16_t* qpl = planes; const bf16_t* ipl = planes + PLANE; bf16_t* fpl = planes + (size_t)(2 + dir) * PLANE;
        f32x4 S[8];
#pragma unroll
        for (int m = 0; m < 8; ++m) S[m] = (f32x4){0.f, 0.f, 0.f, 0.f};
#define SCAN_R0(c) ((c) >= 8 ? (b * SEQ + (dir ? SEQ - 1 - 32 * ((c) - 8) : 32 * ((c) - 8))) : (NLAT + b * CTXL + (dir ? CTXL - 1 - 32 * (c) : 32 * (c))))
        u32x4 nk, nv, nq; nq = (u32x4){0u, 0u, 0u, 0u};
        __syncthreads();
        { const size_t off = (size_t)(SCAN_R0(0) + sgn * lp) * 1024 + col; nk = *(const u32x4*)(fpl + off); nv = *(const u32x4*)(ipl + off); }
        *(u32x4*)(Raw + 0 * RT + lp * RLD + 8 * c8) = nk; *(u32x4*)(Raw + 1 * RT + lp * RLD + 8 * c8) = nv;
        { const size_t off = (size_t)(SCAN_R0(1) + sgn * lp) * 1024 + col; nk = *(const u32x4*)(fpl + off); nv = *(const u32x4*)(ipl + off); }
        __syncthreads();
        for (int c = 0; c < 72; ++c) {
            const bool need_o = c >= 8;
            const bf16_t* raw = Raw + (c & 1) * 3 * RT;
            float kk[8], loc[8]; unsigned vb[8]; float qv[8];
            {
                float f[8];
#pragma unroll
                for (int i = 0; i < 8; ++i) { kk[i] = bf2f(raw[(8 * pg + i) * RLD + ch]); f[i] = 1.0f - kk[i]; vb[i] = raw[RT + (8 * pg + i) * RLD + ch]; qv[i] = need_o ? bf2f(raw[2 * RT + (8 * pg + i) * RLD + ch]) : 0.f; }
                float s = 1.0f;
                if (pg < 2) {
#pragma unroll
                    for (int i = 7; i >= 0; --i) { loc[i] = s; s *= f[i]; }
                } else {
#pragma unroll
                    for (int i = 0; i < 8; ++i) { s *= f[i]; loc[i] = s; }
                }
                Pt[pg * 128 + ch] = s;
            }
            __syncthreads();
            {
                const float P0 = Pt[ch], P1 = Pt[128 + ch], P2 = Pt[256 + ch], P3 = Pt[384 + ch];
                const float T1 = P0 * P1, T2 = P2 * P3;
                const float mult = pg == 0 ? P1 : (pg == 3 ? P2 : 1.0f);
                float kh[8], qh[8], qt[8], kt[8];
#pragma unroll
                for (int i = 0; i < 8; ++i) {
                    const float X = loc[i] * mult; const float rX = __builtin_amdgcn_rcpf(X);
                    const float up = pg < 2 ? rX : X, dn = pg < 2 ? X : rX;
                    qt[i] = qv[i] * up; kt[i] = kk[i] * dn; qh[i] = qt[i] * T1; kh[i] = kt[i] * T2;
                }
                *(u32x4*)(KhT + ch * 40 + 8 * pg) = (u32x4){pk2(kh[0], kh[1]), pk2(kh[2], kh[3]), pk2(kh[4], kh[5]), pk2(kh[6], kh[7])};
                *(u32x4*)(VT + ch * 40 + 8 * pg) = (u32x4){vb[0] | (vb[1] << 16), vb[2] | (vb[3] << 16), vb[4] | (vb[5] << 16), vb[6] | (vb[7] << 16)};
                if (pg == 0) EG[ch] = T1 * T2;
                if (need_o) {
#pragma unroll
                    for (int i = 0; i < 8; ++i) { Qh[(8 * pg + i) * RLD + ch] = f2bf(qh[i]); Qt[(8 * pg + i) * RLD + ch] = f2bf(qt[i]); Kt[(8 * pg + i) * RLD + ch] = f2bf(kt[i]); }
                }
            }
            if (c > 8) *(u32x4*)(fpl + (size_t)(SCAN_R0(c - 1) + sgn * lp) * 1024 + col) = *(const u32x4*)(Os + lp * RLD + 8 * c8);
            __syncthreads();
            if (c + 1 < 72) {
                bf16_t* rn = Raw + ((c + 1) & 1) * 3 * RT + lp * RLD + 8 * c8;
                *(u32x4*)rn = nk; *(u32x4*)(rn + RT) = nv; if (c + 1 >= 8) *(u32x4*)(rn + 2 * RT) = nq;
                if (c + 2 < 72) {
                    const size_t off = (size_t)(SCAN_R0(c + 2) + sgn * lp) * 1024 + col;
                    nk = *(const u32x4*)(fpl + off); nv = *(const u32x4*)(ipl + off); if (c + 2 >= 8) nq = *(const u32x4*)(qpl + off);
                }
            }
            const bf16x8 bv = *(const bf16x8*)(VT + (16 * w + l15) * 40 + 8 * g);
            f32x4 o[2]; o[0] = (f32x4){0.f, 0.f, 0.f, 0.f}; o[1] = (f32x4){0.f, 0.f, 0.f, 0.f};
            if (need_o) {
#pragma unroll
                for (int ks = 0; ks < 4; ++ks) {
                    const bf16x8 sb = mkfrag(pk2(S[2 * ks][0], S[2 * ks][1]), pk2(S[2 * ks][2], S[2 * ks][3]), pk2(S[2 * ks + 1][0], S[2 * ks + 1][1]), pk2(S[2 * ks + 1][2], S[2 * ks + 1][3]));
#pragma unroll
                    for (int mt = 0; mt < 2; ++mt) {
                        const bf16_t* ap = Qh + (16 * mt + l15) * RLD + 32 * ks + 4 * g;
                        const u32x2 lo = *(const u32x2*)ap, hi = *(const u32x2*)(ap + 16);
                        o[mt] = MFMA16(mkfrag(lo.x, lo.y, hi.x, hi.y), sb, o[mt]);
                    }
                }
                if (w < 4) {
                    const int tm = w >> 1, sn = w & 1; f32x4 a = {0.f, 0.f, 0.f, 0.f};
                    if (!(tm == 0 && sn == 1)) {
#pragma unroll
                        for (int ks = 0; ks < 4; ++ks) {
                            const bf16x8 af = *(const bf16x8*)(Qt + (16 * tm + l15) * RLD + 32 * ks + 8 * g);
                            const bf16x8 bf = *(const bf16x8*)(Kt + (16 * sn + l15) * RLD + 32 * ks + 8 * g);
                            a = MFMA16(af, bf, a);
                        }
                    }
                    const int s_ = 16 * sn + l15;
#pragma unroll
                    for (int j = 0; j < 4; ++j) { const int t_ = 16 * tm + 4 * g + j; Am[t_ * 40 + s_] = f2bf(s_ <= t_ ? a[j] : 0.f); }
                }
            }
            __syncthreads();
            if (need_o) {
#pragma unroll
                for (int mt = 0; mt < 2; ++mt) { const bf16x8 af = *(const bf16x8*)(Am + (16 * mt + l15) * 40 + 8 * g); o[mt] = MFMA16(af, bv, o[mt]); }
#pragma unroll
                for (int mt = 0; mt < 2; ++mt)
#pragma unroll
                    for (int j = 0; j < 4; ++j) Os[(16 * mt + 4 * g + j) * RLD + 16 * w + l15] = f2bf(o[mt][j]);
            }
#pragma unroll
            for (int m = 0; m < 8; ++m) {
                const f32x4 eg = *(const f32x4*)(EG + 16 * m + 4 * g);
                const bf16x8 af = *(const bf16x8*)(KhT + (16 * m + l15) * 40 + 8 * g);
                S[m] = MFMA16(af, bv, S[m] * eg);
            }
        }
        __syncthreads();
        *(u32x4*)(fpl + (size_t)(SCAN_R0(71) + sgn * lp) * 1024 + col) = *(const u32x4*)(Os + lp * RLD + 8 * c8);
#undef SCAN_R0
    }
    __syncthreads();
}

__device__ __forceinline__ void grid_bar(unsigned* cnt, unsigned target, const int mk_wid) {
    __syncthreads();
    if (mk_tid(mk_wid) == 0) {
        __builtin_amdgcn_fence(__ATOMIC_RELEASE, "agent");
        __hip_atomic_fetch_add(cnt, 1u, __ATOMIC_RELAXED, __HIP_MEMORY_SCOPE_AGENT);
        while (__hip_atomic_load(cnt, __ATOMIC_RELAXED, __HIP_MEMORY_SCOPE_AGENT) < target) __builtin_amdgcn_s_sleep(8);
        __builtin_amdgcn_fence(__ATOMIC_ACQUIRE, "agent");
    }
    __syncthreads();
}
#define XB_TMO      128
#define XB_XCNT(j)  (256  + 64 * (j))
#define XB_XSUB(j)  (1280 + 64 * (j))
#define XB_XGEN(j)  (2304 + 64 * (j))
#define XB_TOP      3328
#define XB_TOPGEN   3392
#define XCD_BAR_WORDS 3456
#define XB_SPIN_CAP (1u << 18)
#define LAS __attribute__((address_space(3)))

__device__ __forceinline__ unsigned xb_ld(unsigned* p)              { return __hip_atomic_load(p, __ATOMIC_RELAXED, __HIP_MEMORY_SCOPE_AGENT); }
__device__ __forceinline__ unsigned xb_add(unsigned* p, unsigned v) { return __hip_atomic_fetch_add(p, v, __ATOMIC_RELAXED, __HIP_MEMORY_SCOPE_AGENT); }
__device__ __forceinline__ unsigned xb_xcc_id() { return (unsigned)__builtin_amdgcn_s_getreg((3 << 11) | 20) & 0xFu; }
#define XB_SPIN(cond, bar) do { unsigned _sp = 0; while (cond) { __builtin_amdgcn_s_sleep(1); \
    if ((++_sp & 255u) == 0u) { if (xb_ld(&(bar)[XB_TMO])) break; if (_sp > XB_SPIN_CAP) { atomicAdd(&(bar)[XB_TMO], 1u); break; } } } } while (0)

struct XcdBarrier {
    unsigned* bar; unsigned x;
    volatile LAS unsigned* st;
};

__device__ __forceinline__ XcdBarrier xcd_barrier_post(unsigned* bar, volatile LAS unsigned* st, const int mk_wid) {
    XcdBarrier b; b.bar = bar; b.x = xb_xcc_id(); b.st = st;
    if (mk_tid(mk_wid) == 0) (void)xb_add(&bar[XB_XCNT(b.x)], 1u);
    return b;
}
__device__ __forceinline__ void xcd_barrier_complete(unsigned* bar, unsigned x, unsigned& nloc, unsigned& nx) {
    const unsigned G = gridDim.x * gridDim.y * gridDim.z;
    unsigned sum, cnt, mine, sp = 0u;
    for (;;) {
        sum = 0u; cnt = 0u; mine = 0u;
#pragma unroll
        for (unsigned j = 0; j < 16; ++j) { const unsigned c = xb_ld(&bar[XB_XCNT(j)]); sum += c; cnt += (c > 0u) ? 1u : 0u; mine = (j == x) ? c : mine; }
        if (sum == G) break;
        __builtin_amdgcn_s_sleep(1);
        if ((++sp & 255u) == 0u) { if (xb_ld(&bar[XB_TMO])) break; if (sp > XB_SPIN_CAP) { atomicAdd(&bar[XB_TMO], 1u); break; } }
    }
    nloc = mine > 0u ? mine : 1u; nx = cnt > 0u ? cnt : 1u;
}

__device__ __forceinline__ void xcd_barrier(const XcdBarrier& b, const int mk_wid) {
    asm volatile("s_waitcnt vmcnt(0)" ::: "memory");
    __syncthreads();
    if (mk_tid(mk_wid) == 0) {
        unsigned* bar = b.bar;
        __builtin_amdgcn_s_waitcnt(0);
        unsigned nloc = b.st[0], nx = b.st[1];
        if (nloc == 0u) { xcd_barrier_complete(bar, b.x, nloc, nx); b.st[0] = nloc; b.st[1] = nx; }
        const unsigned old = xb_add(&bar[XB_XSUB(b.x)], 1u);
        const unsigned gen = old / nloc;
        if (old + 1u == (gen + 1u) * nloc) {
            __builtin_amdgcn_fence(__ATOMIC_RELEASE, "agent");
            asm volatile("s_waitcnt vmcnt(0)" ::: "memory");
            const unsigned og = xb_add(&bar[XB_TOP], 1u);
            const unsigned tg = og / nx;
            if (og + 1u == (tg + 1u) * nx) xb_add(&bar[XB_TOPGEN], 1u);
            else XB_SPIN(xb_ld(&bar[XB_TOPGEN]) == tg, bar);
            __builtin_amdgcn_fence(__ATOMIC_ACQUIRE, "agent");
            xb_add(&bar[XB_XGEN(b.x)], 1u);
            asm volatile("s_waitcnt vmcnt(0)" ::: "memory");
        } else {
            XB_SPIN(xb_ld(&bar[XB_XGEN(b.x)]) == gen, bar);
            __builtin_amdgcn_fence(__ATOMIC_ACQUIRE, "agent");
            asm volatile("s_waitcnt vmcnt(0)" ::: "memory");
        }
    }
    __syncthreads();
}


__global__ void __launch_bounds__(512) mk_fwd(Params P) {
    extern __shared__ __attribute__((aligned(16))) unsigned char lds_raw[];
    cg::grid_group grid = cg::this_grid();
    const int mk_wid = __builtin_amdgcn_readfirstlane((int)(threadIdx.x >> 6));
    PG8_LAS unsigned char* ldsg = (PG8_LAS unsigned char*)lds_raw;
    unsigned char* ws = P.ws;
    bf16_t* bt = (bf16_t*)(ws + WS_BT); float* hctx = (float*)(ws + WS_HCTX); bf16_t* xn = (bf16_t*)(ws + WS_XN);
    float* small = (float*)(ws + WS_SMALL); bf16_t* big = (bf16_t*)(ws + WS_BIG);
    const float* x = P.in[0]; const float* ctx = P.in[2]; const float* norm_g = P.in[6]; float* hl = P.out;
    const float* mod0 = small + SM_MOD; const float* mod1 = small + SM_MOD + 17 * NMOD;
#define IN(k) (P.ph_lo <= (k) && (k) < P.ph_hi)
#if PROBE_MASK
    unsigned long long ptot = 0, ptprev = __builtin_amdgcn_s_memrealtime();
#define PROBE_TICK(k) do { const unsigned long long now_ = __builtin_amdgcn_s_memrealtime(); if ((PROBE_MASK >> (k)) & 1) ptot += now_ - ptprev; ptprev = now_; } while (0)
#else
#define PROBE_TICK(k) do { } while (0)
#endif
    if (P.ph_lo < 0) grid.sync();
    { volatile PG8_LAS unsigned* st0 = (volatile PG8_LAS unsigned*)(ldsg + 131072); if (mk_tid(mk_wid) < 4) st0[mk_tid(mk_wid)] = 0u; }
    __syncthreads();
    XcdBarrier xbar = xcd_barrier_post((unsigned*)(ws + WS_BAR), (volatile PG8_LAS unsigned*)(ldsg + 131072), mk_wid);
#define SEAM(k) do { if (P.ph_lo <= (k) && (k) + 1 < P.ph_hi) xcd_barrier(xbar, mk_wid); PROBE_TICK(k); } while (0)

    bf16_t* xn2 = (bf16_t*)(ws + WS_XN2); float* rss = small + SM_RSS;
    const float* gam = small + SM_GAM;
    float* cparts = (float*)(ws + WS_BIG + 272 * MiB);
    const NormFix nfA{rss, small + SM_BIAS_UPA, 2 * DFF}, nfB{rss, small + SM_BIAS_UPB, 2 * DFF}, nfM0{rss, small + SM_BIAS_MIX, 2048}, nfM1{rss, small + SM_BIAS_MIX, 5120};
    if (IN(0)) mod_phase(lds_raw, P, mk_wid); SEAM(0);
    if (IN(1)) { prep_weights(lds_raw, P, 0, mk_wid); pool_fold(lds_raw, P, mk_wid); bias_phase(lds_raw, P, 0, mk_wid); prenorm_phase(x, ctx, norm_g, mod0, 1, xn, rss, T, mk_wid);
    } SEAM(1);
    if (IN(2)) { EpiSwiGLU E{big, nfA}; run_gemm(ldsg, xn, bt + BT_W13A, T, 2 * DFF, D, E, mk_wid); } SEAM(2);
    if (IN(3)) { EpiRes<true> E{x, hctx, hl, hctx, mod0 + 2 * 1024, gam + 1 * 17 * 1024, xn, rss, cparts, 0.5f, mk_wid}; run_gemm_split(ldsg, big, bt + BT_W2A, D, DFF, E, mk_wid); } SEAM(3);
    if (IN(3)) { ctx_emit_phase(ctx, hctx, cparts, gam + (1 * 17 + 16) * 1024, xn, rss, mk_wid); xcd_barrier(xbar, mk_wid); }
    if (IN(4)) { EpiAB E{big, nfM0}; run_gemm(ldsg, xn, bt + BT_MIXIN, T, 2048, D, E, mk_wid); } SEAM(4);
    if (IN(5)) mixer_ab_phase(lds_raw, P, mk_wid); SEAM(5);
    if (IN(6)) { EpiRes<true> E{hl, hctx, hl, hctx, mod0 + 5 * 1024, gam + 2 * 17 * 1024, xn2, rss, cparts, 1.0f, mk_wid}; run_gemm_split(ldsg, xn, bt + BT_MIXOUT, D, D, E, mk_wid); } SEAM(6);
    if (IN(6)) { ctx_emit_phase(hctx, hctx, cparts, gam + (2 * 17 + 16) * 1024, xn2, rss, mk_wid); xcd_barrier(xbar, mk_wid); }
    if (IN(7)) { EpiSwiGLU E{big, nfB}; run_gemm(ldsg, xn2, bt + BT_W13B, T, 2 * DFF, D, E, mk_wid); } SEAM(7);
    if (IN(8)) { EpiRes<true> E{hl, hctx, hl, hctx, mod0 + 8 * 1024, gam + 3 * 17 * 1024, xn, rss, cparts, 0.5f, mk_wid}; run_gemm_split(ldsg, big, bt + BT_W2B, D, DFF, E, mk_wid);  prep_weights(lds_raw, P, 1, mk_wid, 0, 1264, 0); bias_phase(lds_raw, P, 1, mk_wid, 0); } SEAM(8);
    if (IN(9)) { prep_weights(lds_raw, P, 1, mk_wid, 1264, 1440, 0); ctx_emit_phase(hctx, hctx, cparts, gam + (3 * 17 + 16) * 1024, xn, rss, mk_wid); } SEAM(9);
    if (IN(10)) { EpiSwiGLU E{big, nfA}; run_gemm(ldsg, xn, bt + BT_W13A, T, 2 * DFF, D, E, mk_wid); } SEAM(10);
    if (IN(11)) { EpiRes<true> E{hl, hctx, hl, hctx, mod1 + 2 * 1024, gam + 4 * 17 * 1024, xn, rss, cparts, 0.5f, mk_wid}; run_gemm_split(ldsg, big, bt + BT_W2A, D, DFF, E, mk_wid); } SEAM(11);
    if (IN(11)) { ctx_emit_phase(hctx, hctx, cparts, gam + (4 * 17 + 16) * 1024, xn, rss, mk_wid); xcd_barrier(xbar, mk_wid); }
    if (IN(12)) { EpiHG E{big, nfM1, small + SM_LB}; run_gemm_hg(ldsg, xn, bt + BT_MIXIN, E, mk_wid); } SEAM(12);
    if (IN(13)) scan_phase(lds_raw, P, mk_wid); SEAM(13);
    if (IN(14)) readout_phase(big, P.in[16], xn, mk_wid); SEAM(14);
    if (IN(15)) { EpiRes<true> E{hl, hctx, hl, hctx, mod1 + 5 * 1024, gam + 5 * 17 * 1024, xn2, rss, cparts, 1.0f, mk_wid}; run_gemm(ldsg, xn, bt + BT_MIXOUT, NLAT, D, D, E, mk_wid); } SEAM(15);
    if (IN(16)) { EpiSwiGLU E{big, nfB}; run_gemm(ldsg, xn2, bt + BT_W13B, NLAT, 2 * DFF, D, E, mk_wid); } SEAM(16);
    if (IN(17)) { EpiRes<false> E{hl, hctx, hl, hctx, mod1 + 8 * 1024, nullptr, nullptr, nullptr, cparts, 0.5f, mk_wid}; run_gemm(ldsg, big, bt + BT_W2B, NLAT, D, DFF, E, mk_wid); } SEAM(17);
    if (IN(18)) final_norm_phase(hl, P.in[18], mk_wid);
#if PROBE_MASK
    PROBE_TICK(18);
    if (blockIdx.x == 0) { const unsigned long long tend = __builtin_amdgcn_s_memrealtime(); while (__builtin_amdgcn_s_memrealtime() - tend < (unsigned long long)PROBE_K * ptot) __builtin_amdgcn_s_sleep(32); }
#endif
#undef IN
#undef SEAM
}
}

extern "C" void kernel_launch(void* const* d_in, const int* in_sizes, int n_in, void* d_out, int out_size, void* d_ws, size_t ws_size, hipStream_t stream) {
    static int grid = 0;
    if (grid == 0) {
        if (n_in != 19 || ws_size < mk::WS_END) { fprintf(stderr, "kernel_launch: unexpected n_in %d or ws_size %zu (need %zu)\n", n_in, ws_size, (size_t)mk::WS_END); grid = -1; return; }
        int dev = 0, cus = 0, per_cu = 0;
        hipGetDevice(&dev); hipDeviceGetAttribute(&cus, hipDeviceAttributeMultiprocessorCount, dev);
        if (hipFuncSetAttribute((const void*)mk::mk_fwd, hipFuncAttributeMaxDynamicSharedMemorySize, mk::LDS_BYTES) != hipSuccess) { fprintf(stderr, "kernel_launch: hipFuncSetAttribute failed\n"); grid = -1; return; }
        if (hipOccupancyMaxActiveBlocksPerMultiprocessor(&per_cu, (const void*)mk::mk_fwd, 512, mk::LDS_BYTES) != hipSuccess || per_cu < 1) { per_cu = 1; (void)hipGetLastError(); }
        grid = cus * 1;
        (void)per_cu;
    }
    if (grid < 0) return;
    (void)hipMemsetAsync((char*)d_ws + mk::WS_BAR, 0, 16384, stream);
    mk::Params p{};
    for (int i = 0; i < 19; ++i) p.in[i] = (const float*)d_in[i];
    p.out = (float*)d_out; p.ws = (unsigned char*)d_ws;
#if MK_PER_PHASE
    for (int ph = 0; ph < mk::NPHASE; ++ph) {
        p.ph_lo = ph; p.ph_hi = ph + 1; void* args[] = {&p};
        hipError_t e = hipLaunchCooperativeKernel((const void*)mk::mk_fwd, dim3(grid), dim3(512), args, mk::LDS_BYTES, stream);
        if (e != hipSuccess) { fprintf(stderr, "cooperative launch failed: %s\n", hipGetErrorString(e)); break; }
    }
#else
    p.ph_lo = 0; p.ph_hi = mk::NPHASE; void* args[] = {&p};
    hipError_t e = hipLaunchCooperativeKernel((const void*)mk::mk_fwd, dim3(grid), dim3(512), args, mk::LDS_BYTES, stream);
    if (e != hipSuccess) fprintf(stderr, "cooperative launch failed: %s (grid %d)\n", hipGetErrorString(e), grid);
#endif
}
```

```cpp
#include <hip/hip_runtime.h>
#include <hip/hip_cooperative_groups.h>
#include <cstdio>
#include <type_traits>
namespace cg = cooperative_groups;
#define PROBE_MASK 0x0u
#define PROBE_K 4
#define PROBE_EPI 0

#ifndef MK_PER_PHASE
#define MK_PER_PHASE 0
#endif

__device__ __forceinline__ int mk_tid(int mk_wid) { int l; asm volatile("v_mbcnt_lo_u32_b32 %0, -1, 0\n\tv_mbcnt_hi_u32_b32 %0, -1, %0" : "=v"(l)); return mk_wid * 64 + l; }
namespace pg8 {
#define PG8_LAS __attribute__((address_space(3)))
typedef unsigned short bf16_t;
typedef short bf16x8 __attribute__((ext_vector_type(8)));
typedef float f32x4 __attribute__((ext_vector_type(4)));
typedef unsigned u32x4 __attribute__((ext_vector_type(4)));
constexpr int BM = 256, BK = 64, HALF = 128, HTB = HALF * BK * 2  , STAGE_BYTES = 8 * HTB, NXCD = 8, WGM = 8;

__host__ __device__ __forceinline__ int lds_byte(int r, int c) { const int st = (r >> 4) * 2 + (c >> 5), rr = r & 15, cc = c & 31, ob = rr * 64 + cc * 2; return st * 1024 + (ob ^ (((ob >> 9) & 1) << 5)); }
__host__ __device__ __forceinline__ void stage_rc(int b, int& R, int& C) { const int st = b / 1024, sb = b % 1024, swz = sb ^ (((sb >> 9) & 1) << 5); R = (st >> 1) * 16 + swz / 64; C = (st & 1) * 32 + (swz % 64) / 2; }
__host__ __device__ __forceinline__ int perm32(int rho) { const int n = rho >> 4, i = rho & 15; return 8 * (i >> 2) + 4 * n + (i & 3); }

struct Unit { int pm, pn, k0t, ntu, split; };
struct Gemm { const bf16_t* A; const bf16_t* Bt; int M, N, K; };

struct StaticOrder {
    int nM, nN, nwg, G, c;
    __host__ __device__ void init(int M, int N, int G_, int c_) { nM = M / BM; nN = N / BM; nwg = nM * nN; G = G_; c = c_; }
    __host__ __device__ bool next(int i, Unit& u) const {
        const long L = (long)i * G + c; if (L >= nwg) return false;
        int wgid = (int)L; { const int q = nwg / NXCD, r = nwg % NXCD, xcd = wgid % NXCD, off = wgid / NXCD; wgid = (xcd < r ? xcd * (q + 1) : r * (q + 1) + (xcd - r) * q) + off; }
        const int nig = WGM * nN, gid = wgid / nig, fm = gid * WGM, gsz = (nM - fm) < WGM ? (nM - fm) : WGM;
        u.pm = fm + ((wgid % nig) % gsz); u.pn = (wgid % nig) / gsz; u.k0t = 0; u.ntu = 0; u.split = 0; return true;
    }
    __device__ __forceinline__ void a_ready(const Unit&) const {}
    __device__ __forceinline__ void done(const Unit&) const {}
};

template <class Epi, class Sched, bool STAMP = false>
__device__ __forceinline__ void gemm_phase(PG8_LAS unsigned char* lds, const Gemm g, const Sched S, const Epi E, unsigned long long* stamps, const int mk_wid) {
    const int tid = mk_tid(mk_wid), wid = __builtin_amdgcn_readfirstlane(tid >> 6), lane = tid & 63, wr = wid >> 2, wc = wid & 3, fr = lane & 15, fq = lane >> 4;
    const int K = g.K, nt = K / BK;
    int ts_lo = 0, ts_hi = 0, nts = 0; const unsigned long long rt_entry = STAMP ? (unsigned long long)wall_clock64() : 0ull;
#define PG8_STAMP() do { if (STAMP && wid == 0 && nts < 64) { const unsigned long long _c = (unsigned long long)clock64(); \
        ts_lo = (lane == nts) ? (int)(unsigned)_c : ts_lo; ts_hi = (lane == nts) ? (int)(unsigned)(_c >> 32) : ts_hi; ++nts; } } while (0)
    PG8_STAMP();
    unsigned voffA[2], voffB[2];
#pragma unroll
    for (int i = 0; i < 2; ++i) { int R, C; stage_rc(tid * 16 + i * 8192, R, C); const int Rb = Epi::PERM ? ((R & ~31) + perm32(R & 31)) : R;
        voffA[i] = (unsigned)(R * K + C) * 2u; voffB[i] = (unsigned)(Rb * K + C) * 2u; }
    const size_t kstep = (size_t)(BK * 2);
    const size_t hstep = (size_t)HALF * K * 2;
    const size_t tstep = 2 * hstep;
    const unsigned ldsw = (unsigned)wid * 1024u;
    const int aoff = lds_byte(wr * 64 + fr, fq * 8), boff = lds_byte(wc * 32 + fr, fq * 8);
#define PG8_SA(b, h) (((b) * 2 + (h)) * HTB)
#define PG8_SB(b, h) ((4 + (b) * 2 + (h)) * HTB)
#define PG8_STAGE(bufoff, gbase, voff) do { _Pragma("unroll") for (int _i = 0; _i < 2; ++_i) \
        __builtin_amdgcn_global_load_lds((const unsigned*)((const char*)(gbase) + (voff)[_i]), (PG8_LAS unsigned*)(lds + (bufoff) + ldsw + _i * 8192), 16, 0, 0); } while (0)
#define PG8_LDA(dst, b, h) do { _Pragma("unroll") for (int m = 0; m < 4; ++m) _Pragma("unroll") for (int k = 0; k < 2; ++k) dst[m][k] = *(const PG8_LAS bf16x8*)(lds + PG8_SA(b, h) + aoff + m * 2048 + k * 1024); } while (0)
#define PG8_LDB(dst, b, h) do { _Pragma("unroll") for (int n = 0; n < 2; ++n) _Pragma("unroll") for (int k = 0; k < 2; ++k) dst[n][k] = *(const PG8_LAS bf16x8*)(lds + PG8_SB(b, h) + boff + n * 2048 + k * 1024); } while (0)
#define PG8_MMA(ai, bj, At, Bt) do { __builtin_amdgcn_s_setprio(1); _Pragma("unroll") for (int m = 0; m < 4; ++m) _Pragma("unroll") for (int n = 0; n < 2; ++n) _Pragma("unroll") for (int k = 0; k < 2; ++k) \
        acc[ai][bj][m][n] = __builtin_amdgcn_mfma_f32_16x16x32_bf16(Bt[n][k], At[m][k], acc[ai][bj][m][n], 0, 0, 0); __builtin_amdgcn_s_setprio(0); } while (0)
#define PG8_WAIT_V(n) asm volatile("s_waitcnt vmcnt(" #n ")" ::: "memory")
#define PG8_WAIT_L(n) asm volatile("s_waitcnt lgkmcnt(" #n ")" ::: "memory")
#define PG8_BAR __builtin_amdgcn_s_barrier()
#define PG8_SCHED __builtin_amdgcn_sched_barrier(0)
    Unit cur, nxt; int ui = 0;
    if (!S.next(0, cur)) return;
    f32x4 acc[2][2][4][2];
#pragma unroll
    for (int a = 0; a < 2; ++a)
#pragma unroll
        for (int b = 0; b < 2; ++b)
#pragma unroll
            for (int m = 0; m < 4; ++m)
#pragma unroll
                for (int n = 0; n < 2; ++n) acc[a][b][m][n] = (f32x4){0.f, 0.f, 0.f, 0.f};
    bf16x8 At[4][2], B0[2][2], B1[2][2];
    const char* cA = (const char*)g.A + (size_t)cur.pm * tstep + (size_t)cur.k0t * kstep; const char* cB = (const char*)g.Bt + (size_t)cur.pn * tstep + (size_t)cur.k0t * kstep;
    S.a_ready(cur);
    PG8_STAGE(PG8_SB(0, 0), cB, voffB); PG8_STAGE(PG8_SA(0, 0), cA, voffA); PG8_STAGE(PG8_SB(0, 1), cB + hstep, voffB); PG8_STAGE(PG8_SA(0, 1), cA + hstep, voffA);
    if (wr == 1) PG8_BAR;
    PG8_WAIT_V(4); PG8_BAR;
    PG8_STAGE(PG8_SB(1, 0), cB + kstep, voffB); PG8_STAGE(PG8_SA(1, 0), cA + kstep, voffA); PG8_STAGE(PG8_SB(1, 1), cB + hstep + kstep, voffB);
    PG8_WAIT_V(6); PG8_BAR;
    PG8_STAMP();
    for (;;) {
        const bool has_next = S.next(ui + 1, nxt);
        const char* nA = has_next ? (const char*)g.A + (size_t)nxt.pm * tstep + (size_t)nxt.k0t * kstep : cA; const char* nB = has_next ? (const char*)g.Bt + (size_t)nxt.pn * tstep + (size_t)nxt.k0t * kstep : cB;
        const int cnt = cur.ntu ? cur.ntu : nt;
        for (int t = 0; t < cnt; t += 2) {
            const bool last = (t == cnt - 2);
            const char* a1 = cA + (size_t)(t + 1) * kstep;
            const char* a2 = last ? nA : cA + (size_t)(t + 2) * kstep; const char* b2 = last ? nB : cB + (size_t)(t + 2) * kstep;
            const char* a3 = a2 + kstep; const char* b3 = b2 + kstep;
            if (last && has_next) S.a_ready(nxt);
            PG8_LDB(B0, 0, 0); PG8_SCHED; PG8_LDA(At, 0, 0); PG8_STAGE(PG8_SA(1, 1), a1 + hstep, voffA);
            PG8_WAIT_L(8); PG8_BAR; PG8_WAIT_L(0); PG8_MMA(0, 0, At, B0); PG8_BAR; PG8_SCHED;
            PG8_LDB(B1, 0, 1); PG8_STAGE(PG8_SB(0, 0), b2, voffB);
            PG8_BAR; PG8_WAIT_L(0); PG8_MMA(0, 1, At, B1); PG8_BAR;
            PG8_LDA(At, 0, 1); PG8_STAGE(PG8_SA(0, 0), a2, voffA);
            PG8_BAR; PG8_WAIT_L(0); PG8_MMA(1, 0, At, B0); PG8_BAR; PG8_SCHED;
            PG8_STAGE(PG8_SB(0, 1), b2 + hstep, voffB);
            PG8_WAIT_V(6); PG8_BAR; PG8_MMA(1, 1, At, B1); PG8_BAR;
            PG8_LDB(B0, 1, 0); PG8_SCHED; PG8_LDA(At, 1, 0); PG8_STAGE(PG8_SA(0, 1), a2 + hstep, voffA);
            PG8_WAIT_L(8); PG8_BAR; PG8_WAIT_L(0); PG8_MMA(0, 0, At, B0); PG8_BAR; PG8_SCHED;
            PG8_LDB(B1, 1, 1); PG8_STAGE(PG8_SB(1, 0), b3, voffB);
            PG8_BAR; PG8_WAIT_L(0); PG8_MMA(0, 1, At, B1); PG8_BAR;
            PG8_LDA(At, 1, 1); PG8_STAGE(PG8_SA(1, 0), a3, voffA);
            PG8_BAR; PG8_WAIT_L(0); PG8_MMA(1, 0, At, B0); PG8_BAR; PG8_SCHED;
            PG8_STAGE(PG8_SB(1, 1), b3 + hstep, voffB);
            PG8_WAIT_V(6); PG8_BAR; PG8_MMA(1, 1, At, B1); PG8_BAR;
        }
        PG8_STAMP();
        if constexpr (!Epi::AFTER_DRAIN) { E(acc, cur, wr, wc, fr, fq); S.done(cur); }
        PG8_STAMP();
        if (!has_next) break;
#pragma unroll
        for (int a = 0; a < 2; ++a)
#pragma unroll
            for (int b = 0; b < 2; ++b)
#pragma unroll
                for (int m = 0; m < 4; ++m)
#pragma unroll
                    for (int n = 0; n < 2; ++n) acc[a][b][m][n] = (f32x4){0.f, 0.f, 0.f, 0.f};
        cur = nxt; cA = nA; cB = nB; ++ui;
    }
    PG8_WAIT_V(0);
    if (wr == 0) PG8_BAR;
    PG8_BAR;
    if constexpr (Epi::AFTER_DRAIN) { E.fused(acc, cur, wr, wc, fr, fq, lds, wid, lane); S.done(cur); }
    PG8_STAMP();
    if (STAMP && wid == 0) { stamps[lane] = lane < nts ? (((unsigned long long)(unsigned)ts_hi << 32) | (unsigned)ts_lo) : 0ull;
        if (lane == 62) stamps[62] = rt_entry; if (lane == 63) stamps[63] = (unsigned long long)wall_clock64(); }
#undef PG8_STAMP
#undef PG8_SA
#undef PG8_SB
#undef PG8_STAGE
#undef PG8_LDA
#undef PG8_LDB
#undef PG8_MMA
#undef PG8_WAIT_V
#undef PG8_WAIT_L
#undef PG8_BAR
#undef PG8_SCHED
}
}

namespace mk {
using pg8::bf16_t; using pg8::bf16x8; using pg8::f32x4; using pg8::u32x4;
typedef unsigned u32x2 __attribute__((ext_vector_type(2)));

constexpr int D = 1024, NB = 16, SEQ = 2048, CTXL = 256, NLAT = NB * SEQ, NCTX = NB * CTXL, T = NLAT + NCTX, DFF = 2816;
constexpr int NMOD = 9 * 1024;
constexpr float EPS = 1e-6f;
constexpr int LDS_BYTES = 131072 + 1024;
constexpr int NPHASE = 19;

constexpr size_t MiB = (size_t)1 << 20;
constexpr size_t WS_BT = 0, WS_HCTX = 48 * MiB, WS_XN = 64 * MiB, WS_SMALL = 136 * MiB, WS_BIG = 144 * MiB, WS_END = 504 * MiB;
constexpr size_t BT_W13A = 0, BT_W2A = 5767168, BT_MIXIN = 8650752, BT_MIXOUT = 13893632, BT_W13B = 14942208, BT_W2B = 20709376;
constexpr size_t SM_MOD = 0  , SM_LB = 2 * 17 * 9216  ;
constexpr size_t SM_GAM = SM_LB + 2048;
constexpr size_t SM_BIAS_UPA = SM_GAM + 6 * 17 * 1024;
constexpr size_t SM_BIAS_MIX = SM_BIAS_UPA + 17 * 5632;
constexpr size_t SM_BIAS_UPB = SM_BIAS_MIX + 17 * 5120;
constexpr size_t SM_RSS = SM_BIAS_UPB + 17 * 5632;
constexpr size_t WS_XN2 = WS_BIG + 200 * MiB;
constexpr size_t WS_BAR = WS_SMALL + 7 * MiB;
constexpr size_t AB_Q = 0, AB_K = (size_t)T * 512, AB_VTL = 2 * (size_t)T * 512, AB_VTC = AB_VTL + (size_t)NB * 512 * SEQ, AB_U = AB_VTC + (size_t)NB * 512 * CTXL;
constexpr size_t PLANE = (size_t)T * 1024;

struct Params { const float* in[19]; float* out; unsigned char* ws; int ph_lo, ph_hi; };

__device__ __forceinline__ unsigned pk2(float lo, float hi) { unsigned r; asm("v_cvt_pk_bf16_f32 %0, %1, %2" : "=v"(r) : "v"(lo), "v"(hi)); return r; }
__device__ __forceinline__ bf16_t f2bf(float x) { unsigned u = __float_as_uint(x); u += 0x7fffu + ((u >> 16) & 1u); return (bf16_t)(u >> 16); }
__device__ __forceinline__ float bflo(unsigned v) { return __uint_as_float(v << 16); }
__device__ __forceinline__ float bfhi(unsigned v) { return __uint_as_float(v & 0xffff0000u); }
__device__ __forceinline__ float bf2f(bf16_t v) { return __uint_as_float((unsigned)v << 16); }
__device__ __forceinline__ float silu_f(float a) { return a * __builtin_amdgcn_rcpf(1.0f + __expf(-a)); }
__device__ __forceinline__ bf16x8 mkfrag(unsigned a, unsigned b, unsigned c, unsigned d) { u32x4 w = {a, b, c, d}; return __builtin_bit_cast(bf16x8, w); }
#define MFMA16(a, b, c) __builtin_amdgcn_mfma_f32_16x16x32_bf16((a), (b), (c), 0, 0, 0)

struct NormFix { const float* rss; const float* bias; int N; };
__device__ __forceinline__ void load_rowscale(const NormFix& nf, const pg8::Unit& u, int wr, int fr, int fq, float (&r)[2][4]) {
#pragma unroll
    for (int ai = 0; ai < 2; ++ai)
#pragma unroll
        for (int m = 0; m < 4; ++m) {
            const int row = u.pm * 256 + ai * 128 + wr * 64 + m * 16 + fr;
            const f32x4 p = *(const f32x4*)(nf.rss + (size_t)row * 16 + 4 * fq);
            float s = (p[0] + p[1]) + (p[2] + p[3]);
            s += __shfl_xor(s, 16); s += __shfl_xor(s, 32);
            r[ai][m] = rsqrtf(s * (1.0f / 1024.0f) + EPS);
        }
}
__device__ __forceinline__ void load_bias(const NormFix& nf, const pg8::Unit& u, int wc, int fq, f32x4 (&bv)[2][2]) {
    const int row0 = u.pm * 256; const int j = row0 < NLAT ? (row0 >> 11) : 16;
    const float* bp = nf.bias + (size_t)j * nf.N + u.pn * 256 + wc * 32 + 4 * fq;
#pragma unroll
    for (int bj = 0; bj < 2; ++bj)
#pragma unroll
        for (int n = 0; n < 2; ++n) bv[bj][n] = *(const f32x4*)(bp + bj * 128 + n * 16);
}
struct EpiSwiGLU {
    static constexpr bool PERM = false, AFTER_DRAIN = false;
    bf16_t* act; NormFix nf;
    __device__ __forceinline__ void operator()(const f32x4 (&acc)[2][2][4][2], const pg8::Unit& u, int wr, int wc, int fr, int fq) const {
        const int row0 = u.pm * 256 + wr * 64 + fr;
        float r[2][4]; f32x4 bv[2][2]; load_rowscale(nf, u, wr, fr, fq, r); load_bias(nf, u, wc, fq, bv);
#pragma unroll
        for (int ai = 0; ai < 2; ++ai)
#pragma unroll
            for (int m = 0; m < 4; ++m) {
                bf16_t* rowp = act + (size_t)(row0 + ai * 128 + m * 16) * DFF + 4 * fq;
#pragma unroll
                for (int bj = 0; bj < 2; ++bj) {
                    const int g32 = 8 * u.pn + 4 * bj + wc;
                    const f32x4 a = acc[ai][bj][m][0] * r[ai][m] + bv[bj][0], b = acc[ai][bj][m][1] * r[ai][m] + bv[bj][1];
                    u32x2 w; w.x = pk2(silu_f(a[0]) * b[0], silu_f(a[1]) * b[1]); w.y = pk2(silu_f(a[2]) * b[2], silu_f(a[3]) * b[3]);
                    *(u32x2*)(rowp + 16 * g32) = w;
                }
            }
    }
};
template <bool EMIT>
struct EpiRes {
    static constexpr bool PERM = false, AFTER_DRAIN = false;
    const float* base_l; const float* base_c; float* out_l; float* out_c; const float* gate;
    const float* gam; bf16_t* xo; float* rss; float* parts; float coef; int wid;
    __device__ __forceinline__ void operator()(const f32x4 (&acc)[2][2][4][2], const pg8::Unit& u, int wr, int wc, int fr_, int fq_) const {
        const int lane_ = mk_tid(wid) & 63; const int fr = lane_ & 15, fq = lane_ >> 4;
        const int row0 = u.pm * 256; const bool lat = row0 < NLAT; const int j = lat ? (row0 >> 11) : 16;
        const float* bp = lat ? base_l + (size_t)row0 * D : base_c + (size_t)(row0 - NLAT) * D;
        float* op = lat ? out_l + (size_t)row0 * D : out_c + (size_t)(row0 - NLAT) * D;
        const int col0 = u.pn * 256 + wc * 32 + 4 * fq;
        const float* gp = gate + (size_t)j * NMOD + col0;
        if (u.split) {
            float* pp = parts + ((size_t)(u.split - 1) * NCTX + (size_t)(row0 - NLAT)) * D;
#pragma unroll
            for (int bj = 0; bj < 2; ++bj)
#pragma unroll
                for (int n = 0; n < 2; ++n) {
                    const f32x4 gq = *(const f32x4*)(gp + bj * 128 + n * 16) * coef;
#pragma unroll
                    for (int gi = 0; gi < 8; ++gi)
                        *(f32x4*)(pp + (size_t)(wr * 64 + fr + (gi >> 2) * 128 + (gi & 3) * 16) * D + col0 + bj * 128 + n * 16) = gq * acc[gi >> 2][bj][gi & 3][n];
                }
            return;
        }
        f32x4 gv[2][2], gm[2][2];
#pragma unroll
        for (int bj = 0; bj < 2; ++bj)
#pragma unroll
            for (int n = 0; n < 2; ++n) {
                gv[bj][n] = *(const f32x4*)(gp + bj * 128 + n * 16) * coef;
                if (EMIT) gm[bj][n] = *(const f32x4*)(gam + (size_t)j * 1024 + col0 + bj * 128 + n * 16);
            }
        f32x4 bs[2][2], bn[2][2];
        {
            const size_t off = (size_t)(wr * 64 + fr) * D + col0;
#pragma unroll
            for (int bj = 0; bj < 2; ++bj)
#pragma unroll
                for (int n = 0; n < 2; ++n) bn[bj][n] = *(const f32x4*)(bp + off + bj * 128 + n * 16);
        }
#pragma unroll
        for (int gi = 0; gi < 8; ++gi) {
            const int ai = gi >> 2, m = gi & 3;
            const int rl = wr * 64 + fr + ai * 128 + m * 16;
            const size_t off = (size_t)rl * D + col0;
#pragma unroll
            for (int bj = 0; bj < 2; ++bj)
#pragma unroll
                for (int n = 0; n < 2; ++n) bs[bj][n] = bn[bj][n];
            if (gi + 1 < 8) {
                const int rl2 = wr * 64 + fr + ((gi + 1) >> 2) * 128 + ((gi + 1) & 3) * 16;
                const size_t off2 = (size_t)rl2 * D + col0;
#pragma unroll
                for (int bj = 0; bj < 2; ++bj)
#pragma unroll
                    for (int n = 0; n < 2; ++n) bn[bj][n] = *(const f32x4*)(bp + off2 + bj * 128 + n * 16);
            }
            float ssq = 0.f;
#pragma unroll
            for (int bj = 0; bj < 2; ++bj)
#pragma unroll
                for (int n = 0; n < 2; ++n) {
                    const f32x4 hv = bs[bj][n] + gv[bj][n] * acc[ai][bj][m][n];
                    *(f32x4*)(op + off + bj * 128 + n * 16) = hv;
                    if (EMIT) {
                        ssq += (hv[0] * hv[0] + hv[1] * hv[1]) + (hv[2] * hv[2] + hv[3] * hv[3]);
                        const f32x4 a = hv * gm[bj][n];
                        u32x2 w; w.x = pk2(a[0], a[1]); w.y = pk2(a[2], a[3]);
                        *(u32x2*)(xo + (size_t)(row0 + rl) * D + col0 + bj * 128 + n * 16) = w;
                    }
                }
            if (EMIT) {
                ssq += __shfl_xor(ssq, 16); ssq += __shfl_xor(ssq, 32);
                if (fq == 0) rss[(size_t)(row0 + rl) * 16 + u.pn * 4 + wc] = ssq;
            }
        }
    }
};
struct EpiAB {
    static constexpr bool PERM = false, AFTER_DRAIN = false;
    bf16_t* big; NormFix nf;
    __device__ __forceinline__ void operator()(const f32x4 (&acc)[2][2][4][2], const pg8::Unit& u, int wr, int wc, int fr, int fq) const {
        const int sect = u.pn >> 1; const int row0 = u.pm * 256 + wr * 64 + fr; const int colbase = (u.pn & 1) * 256 + wc * 32 + 4 * fq;
        float r[2][4]; f32x4 bv[2][2]; load_rowscale(nf, u, wr, fr, fq, r); load_bias(nf, u, wc, fq, bv);
        if (sect != 2) {
            bf16_t* dst = big + (sect == 0 ? AB_Q : (sect == 1 ? AB_K : AB_U)); const float sc = sect == 0 ? 0.125f : 1.0f;
#pragma unroll
            for (int ai = 0; ai < 2; ++ai)
#pragma unroll
                for (int m = 0; m < 4; ++m) {
                    bf16_t* rowp = dst + (size_t)(row0 + ai * 128 + m * 16) * 512 + colbase;
#pragma unroll
                    for (int bj = 0; bj < 2; ++bj)
#pragma unroll
                        for (int n = 0; n < 2; ++n) { const f32x4 v = (acc[ai][bj][m][n] * r[ai][m] + bv[bj][n]) * sc; u32x2 w; w.x = pk2(v[0], v[1]); w.y = pk2(v[2], v[3]); *(u32x2*)(rowp + bj * 128 + n * 16) = w; }
                }
        } else {
            const bool lat = u.pm * 256 < NLAT;
#pragma unroll
            for (int ai = 0; ai < 2; ++ai)
#pragma unroll
                for (int m = 0; m < 4; ++m) {
                    const int row = row0 + ai * 128 + m * 16;
                    bf16_t* bp; size_t sd;
                    if (lat) { const int b = row >> 11, tok = row & 2047; bp = big + AB_VTL + ((size_t)b * 512 + colbase) * SEQ + tok; sd = SEQ; }
                    else { const int rc = row - NLAT; const int b = rc >> 8, tok = rc & 255; bp = big + AB_VTC + ((size_t)b * 512 + colbase) * CTXL + tok; sd = CTXL; }
#pragma unroll
                    for (int bj = 0; bj < 2; ++bj)
#pragma unroll
                        for (int n = 0; n < 2; ++n)
#pragma unroll
                            for (int j = 0; j < 4; ++j) bp[(size_t)(bj * 128 + n * 16 + j) * sd] = f2bf(acc[ai][bj][m][n][j] * r[ai][m] + bv[bj][n][j]);
                }
        }
    }
};
struct EpiHG {
    static constexpr bool PERM = false, AFTER_DRAIN = false;
    bf16_t* planes; NormFix nf; const float* lbv;
    __device__ __forceinline__ void operator()(const f32x4 (&acc)[2][2][4][2], const pg8::Unit& u, int wr, int wc, int fr, int fq) const {
        float r[2][4]; f32x4 bv[2][2]; load_rowscale(nf, u, wr, fr, fq, r); load_bias(nf, u, wc, fq, bv);
        const int plane = u.pn >> 2;
        const bool gate = (plane == 2) || (plane == 3);
        f32x4 oml[2][2];
        if (gate) {
#pragma unroll
            for (int bj = 0; bj < 2; ++bj)
#pragma unroll
                for (int n = 0; n < 2; ++n) oml[bj][n] = 1.0f - *(const f32x4*)(lbv + (plane - 2) * 1024 + (u.pn & 3) * 256 + wc * 32 + 4 * fq + bj * 128 + n * 16);
        } const int row0 = u.pm * 256 + wr * 64 + fr; const int colbase = (u.pn & 3) * 256 + wc * 32 + 4 * fq;
        bf16_t* dst = planes + (size_t)plane * PLANE; const bool act = (plane == 0) || (plane == 4);
#pragma unroll
        for (int ai = 0; ai < 2; ++ai)
#pragma unroll
            for (int m = 0; m < 4; ++m) {
                bf16_t* rowp = dst + (size_t)(row0 + ai * 128 + m * 16) * 1024 + colbase;
#pragma unroll
                for (int bj = 0; bj < 2; ++bj)
#pragma unroll
                    for (int n = 0; n < 2; ++n) {
                        f32x4 v = acc[ai][bj][m][n] * r[ai][m] + bv[bj][n];
                        if (act) { v[0] = silu_f(v[0]); v[1] = silu_f(v[1]); v[2] = silu_f(v[2]); v[3] = silu_f(v[3]); }
                        if (gate) {
#pragma unroll
                            for (int e = 0; e < 4; ++e) v[e] = oml[bj][n][e] * __builtin_amdgcn_rcpf(1.0f + __expf(v[e]));
                        }
                        u32x2 w; w.x = pk2(v[0], v[1]); w.y = pk2(v[2], v[3]); *(u32x2*)(rowp + bj * 128 + n * 16) = w;
                    }
            }
    }
};

struct PrefOrder : pg8::StaticOrder {
    const float* base_l; const float* base_c; PG8_LAS unsigned* sink; int wid;
    __device__ __forceinline__ void a_ready(const pg8::Unit& u) const {
        const int tid = mk_tid(wid);
        const int row0 = u.pm * 256; const float* bp = row0 < NLAT ? base_l + (size_t)row0 * D : base_c + (size_t)(row0 - NLAT) * D;
        bp += u.pn * 256;
#pragma unroll
        for (int i = 0; i < 4; ++i) { const int id = tid + 512 * i; __builtin_amdgcn_global_load_lds((const unsigned*)(bp + (size_t)(id >> 3) * D + (id & 7) * 32), sink, 4, 0, 0); }
    }
};
template <class Epi> __device__ __forceinline__ void run_gemm_res(PG8_LAS unsigned char* lds, const bf16_t* A, const bf16_t* Bt, int M, int N, int K, const Epi E, const int mk_wid) {
    pg8::Gemm g{A, Bt, M, N, K}; PrefOrder S; S.init(M, N, (int)gridDim.x, (int)blockIdx.x);
    S.base_l = E.base_l; S.base_c = E.base_c; S.sink = (PG8_LAS unsigned*)(lds + 131072); S.wid = mk_wid;
    pg8::gemm_phase<Epi, PrefOrder, false>(lds, g, S, E, nullptr, mk_wid);
}
struct SplitOrder {
    pg8::StaticOrder lat; int G, c, ntf;
    __device__ __forceinline__ void init(int N, int K, int G_, int c_) { lat.init(NLAT, N, G_, c_); G = G_; c = c_; ntf = K / 64; }
    __device__ __forceinline__ bool next(int i, pg8::Unit& u) const {
        const long L = (long)i * G + c;
        int pm = 0, pn = 0, k0t = 0, ntu = 0, split = 0; bool ok = true;
        if (L < lat.nwg) { pg8::Unit t; ok = lat.next(i, t); pm = t.pm; pn = t.pn; }
        else {
            const int idx = (int)(L - lat.nwg); ok = idx < 64 * 4;
            const int tile = idx >> 2, part = idx & 3;
            pm = 128 + (tile >> 2); pn = tile & 3; split = 1 + part;
            const int q = ntf >> 2, odd = q & 1, po = part & 1;
            k0t = q * part + (odd & po); ntu = q + odd * (1 - 2 * po);
        }
        u.pm = pm; u.pn = pn; u.k0t = k0t; u.ntu = ntu; u.split = split;
        return ok;
    }
    __device__ __forceinline__ void a_ready(const pg8::Unit&) const {}
    __device__ __forceinline__ void done(const pg8::Unit&) const {}
};
template <class Epi> __device__ __forceinline__ void run_gemm_split(PG8_LAS unsigned char* lds, const bf16_t* A, const bf16_t* Bt, int N, int K, const Epi E, const int mk_wid) {
    pg8::Gemm g{A, Bt, T, N, K}; SplitOrder S; S.init(N, K, (int)gridDim.x, (int)blockIdx.x);
    pg8::gemm_phase<Epi, SplitOrder, false>(lds, g, S, E, nullptr, mk_wid);
}
struct HgOrder {
    pg8::StaticOrder lat; int G, c;
    __device__ __forceinline__ void init(int G_, int c_) { lat.init(NLAT, 5120, G_, c_); G = G_; c = c_; }
    __device__ __forceinline__ bool next(int i, pg8::Unit& u) const {
        const long L = (long)i * G + c;
        int pm = 0, pn = 0; bool ok = true;
        if (L < lat.nwg) { pg8::Unit t; ok = lat.next(i, t); pm = t.pm; pn = t.pn; }
        else { const int idx = (int)(L - lat.nwg); ok = idx < 16 * 12; pm = 128 + idx / 12; pn = 4 + idx % 12; }
        u.pm = pm; u.pn = pn; u.k0t = 0; u.ntu = 0; u.split = 0;
        return ok;
    }
    __device__ __forceinline__ void a_ready(const pg8::Unit&) const {}
    __device__ __forceinline__ void done(const pg8::Unit&) const {}
};
template <class Epi> __device__ __forceinline__ void run_gemm_hg(PG8_LAS unsigned char* lds, const bf16_t* A, const bf16_t* Bt, const Epi E, const int mk_wid) {
    pg8::Gemm g{A, Bt, T, 5120, D}; HgOrder S; S.init((int)gridDim.x, (int)blockIdx.x);
    pg8::gemm_phase<Epi, HgOrder, false>(lds, g, S, E, nullptr, mk_wid);
}
template <class Epi> __device__ __forceinline__ void run_gemm(PG8_LAS unsigned char* lds, const bf16_t* A, const bf16_t* Bt, int M, int N, int K, const Epi E, const int mk_wid) {
    pg8::Gemm g{A, Bt, M, N, K}; pg8::StaticOrder S; S.init(M, N, (int)gridDim.x, (int)blockIdx.x);
    pg8::gemm_phase<Epi, pg8::StaticOrder, false>(lds, g, S, E, nullptr, mk_wid);
}

struct ConvJob { const float* src; bf16_t* dst; int ld, dstld, K, N, mode; };
__device__ __forceinline__ void conv_tile(unsigned char* lds, const ConvJob jb, int tile, const int mk_wid) {
    float* tl = (float*)lds;
    const int tid = mk_tid(mk_wid); const int ktiles = jb.K >> 8; const int rt = tile / ktiles, kt = tile - rt * ktiles; const int r0 = rt * 64, k0 = kt * 256;
    {
        const int r = tid & 63, kk = tid >> 6; const int rho = r0 + r; int col = rho;
        if (jb.mode == 1) col = ((rho >> 4) & 1) * DFF + 16 * (rho >> 5) + (rho & 15);
        const float* sp = jb.src + (size_t)(k0 + kk) * jb.ld + col;
        float v[32];
#pragma unroll
        for (int i = 0; i < 32; ++i) { v[i] = *sp; sp += (size_t)8 * jb.ld; }
#pragma unroll
        for (int i = 0; i < 32; ++i) tl[(kk + 8 * i) * 65 + r] = v[i];
    }
    __syncthreads();
#pragma unroll
    for (int i = 0; i < 4; ++i) {
        const int q = tid + 512 * i; const int r = ((q >> 6) & 7) * 8 + (q & 7), ks = (q >> 9) * 8 + ((q >> 3) & 7); float v[8];
#pragma unroll
        for (int e = 0; e < 8; ++e) v[e] = tl[(ks * 8 + e) * 65 + r];
        u32x4 w; w.x = pk2(v[0], v[1]); w.y = pk2(v[2], v[3]); w.z = pk2(v[4], v[5]); w.w = pk2(v[6], v[7]);
        *(u32x4*)(jb.dst + (size_t)(r0 + r) * jb.dstld + k0 + ks * 8) = w;
    }
    __syncthreads();
}
__device__ __forceinline__ void prep_weights(unsigned char* lds, const Params& P, int layer, const int mk_wid, int t_lo = 0, int t_hi = 1 << 30, int wg0 = 0) {
    bf16_t* bt = (bf16_t*)(P.ws + WS_BT);
    const float* w13 = P.in[7]; const float* w2 = P.in[8];
    const int b1 = 352, b2 = 528, b3 = layer == 0 ? 656 : 848, b4 = layer == 0 ? 688 : 912, b5 = b4 + 352, b6 = b5 + 176;
    if ((int)blockIdx.x < wg0) return;
    const int t_end = t_hi < b6 ? t_hi : b6;
    for (int t = t_lo + (int)blockIdx.x - wg0; t < t_end; t += (int)gridDim.x - wg0) {
        ConvJob jb; int tile;
        if (t < b1) { jb.src = w13 + (size_t)(layer * 2 + 0) * 1024 * 5632; jb.dst = bt + BT_W13A; jb.ld = 5632; jb.dstld = 1024; jb.K = 1024; jb.N = 5632; jb.mode = 1; tile = t; }
        else if (t < b2) { jb.src = w2 + (size_t)(layer * 2 + 0) * 2816 * 1024; jb.dst = bt + BT_W2A; jb.ld = 1024; jb.dstld = 2816; jb.K = 2816; jb.N = 1024; jb.mode = 0; tile = t - b1; }
        else if (t < b3) {
            if (layer == 0) { jb.src = P.in[9]; jb.ld = 2048; jb.N = 2048; } else { jb.src = P.in[14]; jb.ld = 5120; jb.N = 5120; }
            jb.dst = bt + BT_MIXIN; jb.dstld = 1024; jb.K = 1024; jb.mode = 0; tile = t - b2; }
        else if (t < b4) {
            if (layer == 0) { jb.src = P.in[13]; jb.K = 512; } else { jb.src = P.in[17]; jb.K = 1024; }
            jb.dst = bt + BT_MIXOUT; jb.ld = 1024; jb.dstld = 1024; jb.N = 1024; jb.mode = 0; tile = t - b3; }
        else if (t < b5) { jb.src = w13 + (size_t)(layer * 2 + 1) * 1024 * 5632; jb.dst = bt + BT_W13B; jb.ld = 5632; jb.dstld = 1024; jb.K = 1024; jb.N = 5632; jb.mode = 1; tile = t - b4; }
        else { jb.src = w2 + (size_t)(layer * 2 + 1) * 2816 * 1024; jb.dst = bt + BT_W2B; jb.ld = 1024; jb.dstld = 2816; jb.K = 2816; jb.N = 1024; jb.mode = 0; tile = t - b5; }
        conv_tile(lds, jb, tile, mk_wid);
    }
}
__device__ __forceinline__ void pool_fold(unsigned char* lds, const Params& P, const int mk_wid) {
    float* As = (float*)lds;
    float* Bs = As + 128 * 132;
    bf16_t* bto = (bf16_t*)(P.ws + WS_BT) + BT_MIXOUT; const float* pw = P.in[11]; const float* ps = P.in[12]; const float* wo = P.in[13];
    const int tid = mk_tid(mk_wid);
    for (int item = blockIdx.x; item < 64; item += gridDim.x) {
        const int g = item >> 4, nb = item & 15;
        __syncthreads();
#pragma unroll
        for (int i = 0; i < 8; ++i) { const int idx = tid + 512 * i; const int c = idx >> 5, d4 = (idx & 31) * 4;
            const f32x4 a = *(const f32x4*)(pw + (size_t)(g * 128 + c) * 128 + d4), s = *(const f32x4*)(ps + g * 128 + d4); *(f32x4*)(As + c * 132 + d4) = a * s; }
#pragma unroll
        for (int i = 0; i < 4; ++i) { const int idx = tid + 512 * i; const int d = idx >> 4, n4 = (idx & 15) * 4;
            *(f32x4*)(Bs + d * 64 + n4) = *(const f32x4*)(wo + (size_t)(512 + g * 128 + d) * 1024 + nb * 64 + n4); }
        __syncthreads();
        const int n = tid & 63, cg = tid >> 6; float acc[16];
#pragma unroll
        for (int i = 0; i < 16; ++i) acc[i] = 0.f;
#pragma unroll 2
        for (int d = 0; d < 128; d += 4) {
            const float b0 = Bs[(d + 0) * 64 + n], b1 = Bs[(d + 1) * 64 + n], b2 = Bs[(d + 2) * 64 + n], b3 = Bs[(d + 3) * 64 + n];
#pragma unroll
            for (int i = 0; i < 16; ++i) { const f32x4 a = *(const f32x4*)(As + (cg * 16 + i) * 132 + d); acc[i] += a[0] * b0 + a[1] * b1 + a[2] * b2 + a[3] * b3; }
        }
        u32x4 w0, w1;
#pragma unroll
        for (int q = 0; q < 4; ++q) { w0[q] = pk2(acc[2 * q], acc[2 * q + 1]); w1[q] = pk2(acc[8 + 2 * q], acc[8 + 2 * q + 1]); }
        bf16_t* dp = bto + (size_t)(nb * 64 + n) * 1024 + 512 + g * 128 + cg * 16;
        *(u32x4*)dp = w0; *(u32x4*)(dp + 8) = w1;
    }
    __syncthreads();
}
__device__ __forceinline__ void gemv17_item(const float* sc, float* red, const float* wcol4  , size_t ld, float* outp  , size_t outld, const float* badd  , const int mk_wid) {
    const int tid = mk_tid(mk_wid), cl4 = tid & 15, kg = tid >> 4, wv = tid >> 6;
    const float* wp = wcol4 + (size_t)(kg * 32) * ld;
    f32x4 acc[17];
#pragma unroll
    for (int j = 0; j < 17; ++j) acc[j] = (f32x4){0.f, 0.f, 0.f, 0.f};
#pragma unroll 1
    for (int k = 0; k < 32; k += 8) {
        f32x4 w[8];
#pragma unroll
        for (int i = 0; i < 8; ++i) { w[i] = *(const f32x4*)wp; wp += ld; }
#pragma unroll
        for (int q = 0; q < 2; ++q) {
#pragma unroll
            for (int j = 0; j < 17; ++j) { const f32x4 s = *(const f32x4*)(sc + j * 1024 + kg * 32 + k + 4 * q); acc[j] += w[4 * q] * s[0] + w[4 * q + 1] * s[1] + w[4 * q + 2] * s[2] + w[4 * q + 3] * s[3]; }
            __builtin_amdgcn_sched_barrier(0);
        }
    }
#pragma unroll
    for (int j = 0; j < 17; ++j) {
#pragma unroll
        for (int e = 0; e < 4; ++e) { float v = acc[j][e]; v += __shfl_xor(v, 16); v += __shfl_xor(v, 32); acc[j][e] = v; }
        if ((tid & 63) < 16) *(f32x4*)(red + (wv * 17 + j) * 64 + 4 * cl4) = acc[j];
    }
    __syncthreads();
    for (int o = tid; o < 17 * 64; o += 512) {
        const int j = o >> 6, c2 = o & 63; float s = 0.f;
#pragma unroll
        for (int q = 0; q < 8; ++q) s += red[(q * 17 + j) * 64 + c2];
        outp[(size_t)j * outld + c2] = s + (badd ? badd[c2] : 0.f);
    }
    __syncthreads();
}
__device__ __forceinline__ void mod_phase(unsigned char* lds, const Params& P, const int mk_wid) {
    float* sc = (float*)lds;
    float* red = sc + 17 * 1024;
    const int tid = mk_tid(mk_wid); const float* c = P.in[1]; const float* cc = P.in[3]; const float* wm = P.in[4]; const float* bm = P.in[5];
    float* small = (float*)(P.ws + WS_SMALL);
    for (int i = blockIdx.x * 512 + tid; i < 2048; i += gridDim.x * 512) { const float l0 = P.in[15][i], l1 = P.in[15][2048 + i]; small[SM_LB + i] = 1.0f / (1.0f + __expf(l0 - l1)); }
    for (int idx = tid; idx < 17 * 1024; idx += 512) { const int j = idx >> 10, k = idx & 1023; const float v = j < 16 ? c[j * 1024 + k] : cc[k]; sc[idx] = v / (1.0f + __expf(-v)); }
    __syncthreads();
    for (int item = blockIdx.x; item < 288; item += gridDim.x) {
        const int l = item / 144, nb = item - l * 144;
        gemv17_item(sc, red, wm + (size_t)l * 1024 * NMOD + nb * 64 + 4 * (tid & 15), NMOD, small + SM_MOD + (size_t)l * 17 * NMOD + nb * 64, NMOD, bm + l * NMOD + nb * 64, mk_wid);
    }
}
__device__ __forceinline__ void bias_phase(unsigned char* lds, const Params& P, int layer, const int mk_wid, int wg0 = 0) {
    float* sc = (float*)lds; float* red = sc + 17 * 1024; const int tid = mk_tid(mk_wid);
    float* small = (float*)(P.ws + WS_SMALL); const float* modl = small + SM_MOD + (size_t)layer * 17 * NMOD;
    const int nmix = layer == 0 ? 32 : 80; const int nitems = 88 + nmix + 88;
    int staged = -1;
    for (int item = (int)blockIdx.x - wg0; item >= 0 && item < nitems; item += (int)gridDim.x - wg0) {
        const int which = item < 88 ? 0 : (item < 88 + nmix ? 1 : 2); const int nb = which == 0 ? item : (which == 1 ? item - 88 : item - 88 - nmix);
        if (staged != which) {
            __syncthreads();
            for (int idx = tid; idx < 17 * 1024; idx += 512) { const int j = idx >> 10, k = idx & 1023; sc[idx] = modl[(size_t)j * NMOD + (3 * which) * 1024 + k]; }
            __syncthreads(); staged = which;
        }
        const int rho = nb * 64 + 4 * (tid & 15);
        const float* wsrc; size_t ld; float* outp;
        if (which == 1) { ld = layer == 0 ? 2048 : 5120; wsrc = (layer == 0 ? P.in[9] : P.in[14]) + rho; outp = small + SM_BIAS_MIX + nb * 64; }
        else {
            ld = 5632; wsrc = P.in[7] + (size_t)(layer * 2 + (which == 2 ? 1 : 0)) * 1024 * 5632 + (((rho >> 4) & 1) * DFF + 16 * (rho >> 5) + (rho & 15));
            outp = small + (which == 0 ? SM_BIAS_UPA : SM_BIAS_UPB) + nb * 64;
        }
        gemv17_item(sc, red, wsrc, ld, outp, ld, nullptr, mk_wid);
    }
    if (layer == 0) {
        const float* ng = P.in[6];
        for (int i = blockIdx.x * 512 + tid; i < 6 * 17 * 1024; i += gridDim.x * 512) {
            const int s = i / (17 * 1024), rem = i - s * 17 * 1024, j = rem >> 10, c = rem & 1023, l = s / 3, k = s - 3 * l;
            small[SM_GAM + i] = ng[s * 1024 + c] * (1.0f + small[SM_MOD + ((size_t)l * 17 + j) * NMOD + (3 * k + 1) * 1024 + c]);
        }
    }
}

__device__ __forceinline__ float wave_sum(float v) {
#pragma unroll
    for (int o = 32; o >= 1; o >>= 1) v += __shfl_xor(v, o);
    return v;
}
__device__ __forceinline__ void prenorm_phase(const float* hl, const float* hc, const float* g, const float* modl, int sc_idx, bf16_t* xn, float* rss, int nrows, const int mk_wid) {
    const int lane = mk_tid(mk_wid) & 63; const int gw = blockIdx.x * 8 + (mk_tid(mk_wid) >> 6), nw = gridDim.x * 8;
    for (int row0 = 2 * gw; row0 < nrows; row0 += 2 * nw) {
        f32x4 v[2][4]; float ss[2];
#pragma unroll
        for (int rr = 0; rr < 2; ++rr) {
            const int row = row0 + rr; const bool lat = row < NLAT; const float* src = lat ? hl + (size_t)row * D : hc + (size_t)(row - NLAT) * D;
#pragma unroll
            for (int i = 0; i < 4; ++i) v[rr][i] = *(const f32x4*)(src + i * 256 + lane * 4);
        }
#pragma unroll
        for (int rr = 0; rr < 2; ++rr) {
            float s = 0.f;
#pragma unroll
            for (int i = 0; i < 4; ++i) s += v[rr][i][0] * v[rr][i][0] + v[rr][i][1] * v[rr][i][1] + v[rr][i][2] * v[rr][i][2] + v[rr][i][3] * v[rr][i][3];
            ss[rr] = wave_sum(s);
        }
#pragma unroll
        for (int rr = 0; rr < 2; ++rr) {
            const int row = row0 + rr; const int j = row < NLAT ? (row >> 11) : 16;
            const float* scp = modl + (size_t)j * NMOD + sc_idx * 1024;
            if (lane < 16) rss[(size_t)row * 16 + lane] = lane == 0 ? ss[rr] : 0.f;
#pragma unroll
            for (int i = 0; i < 4; ++i) {
                const int cidx = i * 256 + lane * 4;
                const f32x4 gg = *(const f32x4*)(g + cidx), s1 = *(const f32x4*)(scp + cidx);
                const f32x4 y = v[rr][i] * gg * (s1 + 1.0f);
                u32x2 w; w.x = pk2(y[0], y[1]); w.y = pk2(y[2], y[3]); *(u32x2*)(xn + (size_t)row * D + cidx) = w;
            }
        }
    }
}
__device__ __forceinline__ void ctx_emit_phase(const float* hsrc, float* hc, const float* parts, const float* gamc, bf16_t* xn, float* rss, const int mk_wid) {
    const int lane = mk_tid(mk_wid) & 63; const int gw = blockIdx.x * 8 + (mk_tid(mk_wid) >> 6), nw = gridDim.x * 8;
    for (int rc = gw; rc < NCTX; rc += nw) {
        const float* srcr = hsrc + (size_t)rc * D; float* src = hc + (size_t)rc * D; const int row = NLAT + rc;
        f32x4 v[4]; float ss = 0.f;
#pragma unroll
        for (int i = 0; i < 4; ++i) {
            const size_t o = (size_t)rc * D + i * 256 + lane * 4;
            v[i] = *(const f32x4*)(srcr + i * 256 + lane * 4) + ((*(const f32x4*)(parts + o) + *(const f32x4*)(parts + (size_t)NCTX * D + o)) + (*(const f32x4*)(parts + 2 * (size_t)NCTX * D + o) + *(const f32x4*)(parts + 3 * (size_t)NCTX * D + o)));
            ss += v[i][0] * v[i][0] + v[i][1] * v[i][1] + v[i][2] * v[i][2] + v[i][3] * v[i][3];
        }
        ss = wave_sum(ss);
        if (lane < 16) rss[(size_t)row * 16 + lane] = lane == 0 ? ss : 0.f;
#pragma unroll
        for (int i = 0; i < 4; ++i) {
            const int cidx = i * 256 + lane * 4;
            *(f32x4*)(src + cidx) = v[i];
            const f32x4 y = v[i] * *(const f32x4*)(gamc + cidx);
            u32x2 w; w.x = pk2(y[0], y[1]); w.y = pk2(y[2], y[3]); *(u32x2*)(xn + (size_t)row * D + cidx) = w;
        }
    }
}
__device__ __forceinline__ void final_norm_phase(float* h, const float* g, const int mk_wid) {
    const int lane = mk_tid(mk_wid) & 63; const int gw = blockIdx.x * 8 + (mk_tid(mk_wid) >> 6), nw = gridDim.x * 8;
    for (int row0 = 2 * gw; row0 < NLAT; row0 += 2 * nw) {
        f32x4 v[2][4]; float r[2];
#pragma unroll
        for (int rr = 0; rr < 2; ++rr)
#pragma unroll
            for (int i = 0; i < 4; ++i) v[rr][i] = *(const f32x4*)(h + (size_t)(row0 + rr) * D + i * 256 + lane * 4);
#pragma unroll
        for (int rr = 0; rr < 2; ++rr) {
            float s = 0.f;
#pragma unroll
            for (int i = 0; i < 4; ++i) s += v[rr][i][0] * v[rr][i][0] + v[rr][i][1] * v[rr][i][1] + v[rr][i][2] * v[rr][i][2] + v[rr][i][3] * v[rr][i][3];
            r[rr] = rsqrtf(wave_sum(s) * (1.0f / 1024.0f) + EPS);
        }
#pragma unroll
        for (int rr = 0; rr < 2; ++rr)
#pragma unroll
            for (int i = 0; i < 4; ++i) { const int cidx = i * 256 + lane * 4; const f32x4 gg = *(const f32x4*)(g + cidx); *(f32x4*)(h + (size_t)(row0 + rr) * D + cidx) = v[rr][i] * r[rr] * gg; }
    }
}
__device__ __forceinline__ void readout_phase(const bf16_t* planes, const float* gnorm, bf16_t* dst, const int mk_wid) {
    const int lane = mk_tid(mk_wid) & 63; const int gw = blockIdx.x * 8 + (mk_tid(mk_wid) >> 6), nw = gridDim.x * 8;
    const int c0 = lane * 16;
    float gn[16];
#pragma unroll
    for (int e = 0; e < 16; ++e) gn[e] = gnorm[(c0 + e) & 127];
    for (int row0 = 2 * gw; row0 < NLAT; row0 += 2 * nw) {
        u32x4 a0[2], a1[2], b0[2], b1[2], g0[2], g1[2];
#pragma unroll
        for (int rr = 0; rr < 2; ++rr) {
            const size_t off = (size_t)(row0 + rr) * 1024 + c0;
            a0[rr] = *(const u32x4*)(planes + 2 * PLANE + off); a1[rr] = *(const u32x4*)(planes + 2 * PLANE + off + 8);
            b0[rr] = *(const u32x4*)(planes + 3 * PLANE + off); b1[rr] = *(const u32x4*)(planes + 3 * PLANE + off + 8);
            g0[rr] = *(const u32x4*)(planes + 4 * PLANE + off); g1[rr] = *(const u32x4*)(planes + 4 * PLANE + off + 8);
        }
#pragma unroll
        for (int rr = 0; rr < 2; ++rr) {
            const size_t off = (size_t)(row0 + rr) * 1024 + c0;
            float o[16], sg[16]; float ss = 0.f;
#pragma unroll
            for (int q = 0; q < 4; ++q) {
                o[2 * q] = bflo(a0[rr][q]) + bflo(b0[rr][q]); o[2 * q + 1] = bfhi(a0[rr][q]) + bfhi(b0[rr][q]);
                o[8 + 2 * q] = bflo(a1[rr][q]) + bflo(b1[rr][q]); o[8 + 2 * q + 1] = bfhi(a1[rr][q]) + bfhi(b1[rr][q]);
                sg[2 * q] = bflo(g0[rr][q]); sg[2 * q + 1] = bfhi(g0[rr][q]); sg[8 + 2 * q] = bflo(g1[rr][q]); sg[8 + 2 * q + 1] = bfhi(g1[rr][q]);
            }
#pragma unroll
            for (int e = 0; e < 16; ++e) ss += o[e] * o[e];
            ss += __shfl_xor(ss, 1); ss += __shfl_xor(ss, 2); ss += __shfl_xor(ss, 4);
            const float r = rsqrtf(ss * (1.0f / 128.0f) + EPS);
            u32x4 w0, w1;
#pragma unroll
            for (int q = 0; q < 4; ++q) {
                w0[q] = pk2(o[2 * q] * r * gn[2 * q] * sg[2 * q], o[2 * q + 1] * r * gn[2 * q + 1] * sg[2 * q + 1]);
                w1[q] = pk2(o[8 + 2 * q] * r * gn[8 + 2 * q] * sg[8 + 2 * q], o[8 + 2 * q + 1] * r * gn[8 + 2 * q + 1] * sg[8 + 2 * q + 1]);
            }
            *(u32x4*)(dst + off) = w0; *(u32x4*)(dst + off + 8) = w1;
        }
    }
}

constexpr int KS_LD = 72, VS_LD = 264;
__device__ __forceinline__ void attn_softmax16(f32x4 (&s)[16], float& mx_out, float& sum_out) {
    float mx = -1e30f;
#pragma unroll
    for (int kt = 0; kt < 16; ++kt) mx = fmaxf(fmaxf(fmaxf(s[kt][0], s[kt][1]), fmaxf(s[kt][2], s[kt][3])), mx);
    mx = fmaxf(mx, __shfl_xor(mx, 16)); mx = fmaxf(mx, __shfl_xor(mx, 32));
    float sum = 0.f;
#pragma unroll
    for (int kt = 0; kt < 16; ++kt) {
#pragma unroll
        for (int j = 0; j < 4; ++j) { const float p = __expf(s[kt][j] - mx); s[kt][j] = p; sum += p; }
    }
    sum += __shfl_xor(sum, 16); sum += __shfl_xor(sum, 32);
    mx_out = mx; sum_out = sum;
}
__device__ __forceinline__ bf16x8 attn_pfrag(const f32x4 (&s)[16], int i) {
    return mkfrag(pk2(s[2 * i][0], s[2 * i][1]), pk2(s[2 * i][2], s[2 * i][3]), pk2(s[2 * i + 1][0], s[2 * i + 1][1]), pk2(s[2 * i + 1][2], s[2 * i + 1][3]));
}
__device__ __forceinline__ void attn_ctx_half(const bf16_t* Ks, const bf16_t* Vs, const bf16x8 (&qf)[2], int lane, float& mx_out, float& sum_out, f32x4 (&o)[4]) {
    const int l15 = lane & 15, g = lane >> 4;
    f32x4 s[16];
#pragma unroll
    for (int kt = 0; kt < 16; ++kt) {
        const bf16_t* kp = Ks + (16 * kt + l15) * KS_LD + 8 * g;
        const bf16x8 k0 = *(const bf16x8*)kp, k1 = *(const bf16x8*)(kp + 32);
        f32x4 a = {0.f, 0.f, 0.f, 0.f};
        a = MFMA16(k0, qf[0], a); a = MFMA16(k1, qf[1], a);
        s[kt] = a;
    }
    attn_softmax16(s, mx_out, sum_out);
#pragma unroll
    for (int mt = 0; mt < 4; ++mt) o[mt] = (f32x4){0.f, 0.f, 0.f, 0.f};
#pragma unroll
    for (int i = 0; i < 8; ++i) {
        const bf16x8 pb = attn_pfrag(s, i);
#pragma unroll
        for (int mt = 0; mt < 4; ++mt) {
            const bf16_t* vp = Vs + (16 * mt + l15) * VS_LD + 32 * i + 4 * g;
            const u32x2 lo = *(const u32x2*)vp, hi = *(const u32x2*)(vp + 16);
            o[mt] = MFMA16(mkfrag(lo.x, lo.y, hi.x, hi.y), pb, o[mt]);
        }
    }
}
__device__ __forceinline__ void attn_ctx_tile(const bf16_t* big, bf16_t* cat, const bf16_t* Ks, const bf16_t* Vs, int b, int h, int qt, int lane) {
    const int l15 = lane & 15, g = lane >> 4;
    const int qrow = NLAT + b * CTXL + 16 * qt + l15;
    bf16x8 qf[2];
#pragma unroll
    for (int ks = 0; ks < 2; ++ks) qf[ks] = *(const bf16x8*)(big + AB_Q + (size_t)qrow * 512 + h * 64 + 32 * ks + 8 * g);
    float m2, l2; f32x4 o[4];
    attn_ctx_half(Ks, Vs, qf, lane, m2, l2, o);
    const float inv = 1.0f / l2;
    bf16_t* op = cat + (size_t)qrow * 1024 + h * 64 + 4 * g;
#pragma unroll
    for (int mt = 0; mt < 4; ++mt) { u32x2 w; w.x = pk2(o[mt][0] * inv, o[mt][1] * inv); w.y = pk2(o[mt][2] * inv, o[mt][3] * inv); *(u32x2*)(op + 16 * mt) = w; }
}
__device__ __forceinline__ void attn_lat_tile(const bf16_t* big, bf16_t* cat, const bf16_t* Ks, const bf16_t* Vs, const float* rp, int b, int h, int r, int n, int lane) {
    const int l15 = lane & 15, g = lane >> 4;
    const int qrow = b * SEQ + r * 64 + 16 * n + l15;
    const int r0 = min(max(r - 4, 0), 24), band0 = min(max(16 * n - 8, 0), 32);
    bf16x8 qf[2];
#pragma unroll
    for (int ks = 0; ks < 2; ++ks) qf[ks] = *(const bf16x8*)(big + AB_Q + (size_t)qrow * 512 + h * 64 + 32 * ks + 8 * g);
    const bf16_t* kbase = big + AB_K + (size_t)(b * SEQ + r0 * 64 + band0 + l15) * 512 + h * 64 + 8 * g;
    bf16x8 kA[8], kB[8];
#define ATT_KLOAD(dst, k0) do { _Pragma("unroll") for (int kk = 0; kk < 4; ++kk) { const int kt_ = (k0) + kk; const bf16_t* kp = kbase + (size_t)((kt_ >> 1) * 64 + 16 * (kt_ & 1)) * 512; \
        dst[2 * kk] = *(const bf16x8*)kp; dst[2 * kk + 1] = *(const bf16x8*)(kp + 32); } } while (0)
#define ATT_QK(src, k0) do { _Pragma("unroll") for (int kk = 0; kk < 4; ++kk) { f32x4 a = {0.f, 0.f, 0.f, 0.f}; a = MFMA16(src[2 * kk], qf[0], a); a = MFMA16(src[2 * kk + 1], qf[1], a); s[(k0) + kk] = a; } } while (0)
    ATT_KLOAD(kA, 0);
    __builtin_amdgcn_sched_barrier(0);
    float m2, l2; f32x4 o2[4];
    attn_ctx_half(Ks, Vs, qf, lane, m2, l2, o2);
    __builtin_amdgcn_sched_barrier(0);
    ATT_KLOAD(kB, 4);
    __builtin_amdgcn_sched_barrier(0);
    f32x4 s[16];
    ATT_QK(kA, 0);
    ATT_KLOAD(kA, 8);
    __builtin_amdgcn_sched_barrier(0);
    ATT_QK(kB, 4);
    ATT_KLOAD(kB, 12);
    __builtin_amdgcn_sched_barrier(0);
    const bf16_t* vbase = big + AB_VTL + ((size_t)b * 512 + h * 64 + l15) * SEQ + r0 * 64 + band0 + 4 * g;
    u32x2 vG[4][8];
#define ATT_VLOAD(dst, i0) do { _Pragma("unroll") for (int mt = 0; mt < 4; ++mt) { \
        const bf16_t* vp = vbase + (size_t)(16 * mt) * SEQ + (i0) * 64; dst[mt * 2] = *(const u32x2*)vp; dst[mt * 2 + 1] = *(const u32x2*)(vp + 16); } } while (0)
#define ATT_PV(src, i0) do { const bf16x8 pb = attn_pfrag(s, (i0)); _Pragma("unroll") for (int mt = 0; mt < 4; ++mt) \
        o1[mt] = MFMA16(mkfrag(src[mt * 2].x, src[mt * 2].y, src[mt * 2 + 1].x, src[mt * 2 + 1].y), pb, o1[mt]); } while (0)
    ATT_QK(kA, 8);
    __builtin_amdgcn_sched_barrier(0);
    ATT_QK(kB, 12);
    __builtin_amdgcn_sched_barrier(0);
#pragma unroll
    for (int i = 0; i < 4; ++i) ATT_VLOAD(vG[i], i);
    __builtin_amdgcn_sched_barrier(0);
#undef ATT_KLOAD
#undef ATT_QK
    {
        const int cq = 16 * n + l15; const int wc0 = min(max(cq - 8, 0), 48);
#pragma unroll
        for (int kt = 0; kt < 16; ++kt) {
            const int rowi = r0 + (kt >> 1) - r + 7;
#pragma unroll
            for (int j = 0; j < 4; ++j) {
                const int kcol = band0 + 16 * (kt & 1) + 4 * g + j;
                const bool ok = (kcol >= wc0) && (kcol < wc0 + 16);
                const int rel = min(max(kcol - cq, -15), 15) + 15;
                const float bias = rp[rowi * 31 + rel];
                s[kt][j] = ok ? s[kt][j] + bias : -1e30f;
            }
        }
    }
    float m1, l1; attn_softmax16(s, m1, l1);
    f32x4 o1[4];
#pragma unroll
    for (int mt = 0; mt < 4; ++mt) o1[mt] = (f32x4){0.f, 0.f, 0.f, 0.f};
#pragma unroll
    for (int i = 0; i < 4; ++i) ATT_PV(vG[i], i);
    __builtin_amdgcn_sched_barrier(0);
#pragma unroll
    for (int i = 0; i < 4; ++i) ATT_VLOAD(vG[i], 4 + i);
    __builtin_amdgcn_sched_barrier(0);
#pragma unroll
    for (int i = 0; i < 4; ++i) ATT_PV(vG[i], 4 + i);
#undef ATT_VLOAD
#undef ATT_PV
    const float m = fmaxf(m1, m2); const float a1 = __expf(m1 - m), a2 = __expf(m2 - m);
    const float inv = 1.0f / (l2 * a2 + l1 * a1);
    bf16_t* op = cat + (size_t)qrow * 1024 + h * 64 + 4 * g;
#pragma unroll
    for (int mt = 0; mt < 4; ++mt) {
        const f32x4 ov = (o2[mt] * a2 + o1[mt] * a1) * inv;
        u32x2 w; w.x = pk2(ov[0], ov[1]); w.y = pk2(ov[2], ov[3]); *(u32x2*)(op + 16 * mt) = w;
    }
}
__device__ __forceinline__ void mixer_ab_phase(unsigned char* lds, const Params& P, const int mk_wid) {
    bf16_t* Ks = (bf16_t*)lds;
    bf16_t* Vs = Ks + 256 * KS_LD;
    float* rpbs = (float*)(Vs + 64 * VS_LD);
    const bf16_t* big = (const bf16_t*)(P.ws + WS_BIG); bf16_t* cat = (bf16_t*)(P.ws + WS_XN);
    const int tid = mk_tid(mk_wid), lane = tid & 63, w = tid >> 6;
    for (int item = blockIdx.x; item < 256; item += gridDim.x) {
        const int half = item & 1, h = (item >> 1) & 7, b = item >> 4;
        __syncthreads();
#pragma unroll
        for (int i = 0; i < 4; ++i) {
            const int q = tid + 512 * i;
            { const int row = q >> 3, part = q & 7; *(u32x4*)(Ks + row * KS_LD + part * 8) = *(const u32x4*)(big + AB_K + (size_t)(NLAT + b * CTXL + row) * 512 + h * 64 + part * 8); }
            { const int d = q >> 5, part = q & 31; *(u32x4*)(Vs + d * VS_LD + part * 8) = *(const u32x4*)(big + AB_VTC + ((size_t)b * 512 + h * 64 + d) * CTXL + part * 8); }
        }
        if (tid < 465) rpbs[tid] = P.in[10][h * 465 + tid];
        __syncthreads();
        for (int it = 0; it < 8; ++it) attn_lat_tile(big, cat, Ks, Vs, rpbs, b, h, half * 16 + 2 * it + (w >> 2), w & 3, lane);
        attn_ctx_tile(big, cat, Ks, Vs, b, h, half * 8 + w, lane);
    }
    __syncthreads();
    const bf16_t* U = big + AB_U;
    for (int idx = blockIdx.x * 512 + tid; idx < T * 64; idx += gridDim.x * 512) {
        const int row = idx >> 6, c8 = idx & 63, ch = c8 * 8, grp = c8 >> 4, wd = 2 << grp, hf = wd >> 1;
        int base, L, t;
        if (row < NLAT) { base = row & ~2047; L = SEQ; t = row & 2047; } else { const int rc = row - NLAT; base = NLAT + (rc & ~255); L = CTXL; t = rc & 255; }
        const int lo = max(t - hf, 0), hi = min(t - hf + wd, L);
        float acc[8];
#pragma unroll
        for (int e = 0; e < 8; ++e) acc[e] = 0.f;
#pragma unroll
        for (int i = 0; i < 16; ++i) {
            const int tt = lo + i;
            u32x4 v = {0u, 0u, 0u, 0u};
            if (tt < hi) v = *(const u32x4*)(U + (size_t)(base + tt) * 512 + ch);
#pragma unroll
            for (int q = 0; q < 4; ++q) { acc[2 * q] += bflo(v[q]); acc[2 * q + 1] += bfhi(v[q]); }
        }
        const u32x4 sv = *(const u32x4*)(U + (size_t)row * 512 + ch);
        const float invn = 1.0f / (float)(hi - lo);
        u32x4 w4;
#pragma unroll
        for (int q = 0; q < 4; ++q) w4[q] = pk2(acc[2 * q] * invn - bflo(sv[q]), acc[2 * q + 1] * invn - bfhi(sv[q]));
        *(u32x4*)(cat + (size_t)row * 1024 + 512 + ch) = w4;
    }
}

__device__ __forceinline__ void scan_phase(unsigned char* lds, const Params& P, const int mk_wid) {
    constexpr int RLD = 136, RT = 32 * RLD;
    bf16_t* Raw = (bf16_t*)lds;
    float* Pt = (float*)(lds + 2 * 3 * RT * 2);
    float* EG = Pt + 512;
    bf16_t* Qh = (bf16_t*)(EG + 128);
    bf16_t* Qt = Qh + RT;
    bf16_t* Kt = Qt + RT;
    bf16_t* KhT = Kt + RT;
    bf16_t* VT = KhT + 128 * 40;
    bf16_t* Am = VT + 128 * 40;
    bf16_t* Os = Am + 32 * 40;
    bf16_t* planes = (bf16_t*)(P.ws + WS_BIG);
    const int tid = mk_tid(mk_wid), lane = tid & 63, w = tid >> 6, g = lane >> 4, l15 = lane & 15;
    const int lp = tid >> 4, c8 = tid & 15;
    const int ch = tid & 127, pg = tid >> 7;
    for (int chain = blockIdx.x; chain < 256; chain += gridDim.x) {
        const int dir = chain & 1, h = (chain >> 1) & 7, b = chain >> 4;
        const int col = h * 128 + 8 * c8; const int sgn = dir ? -1 : 1;
        const bf16_t* qpl = planes; const bf16_t* ipl = planes + PLANE; bf16_t* fpl = planes + (size_t)(2 + dir) * PLANE;
        f32x4 S[8];
#pragma unroll
        for (int m = 0; m < 8; ++m) S[m] = (f32x4){0.f, 0.f, 0.f, 0.f};
#define SCAN_R0(c) ((c) >= 8 ? (b * SEQ + (dir ? SEQ - 1 - 32 * ((c) - 8) : 32 * ((c) - 8))) : (NLAT + b * CTXL + (dir ? CTXL - 1 - 32 * (c) : 32 * (c))))
        u32x4 nk, nv, nq; nq = (u32x4){0u, 0u, 0u, 0u};
        __syncthreads();
        { const size_t off = (size_t)(SCAN_R0(0) + sgn * lp) * 1024 + col; nk = *(const u32x4*)(fpl + off); nv = *(const u32x4*)(ipl + off); }
        *(u32x4*)(Raw + 0 * RT + lp * RLD + 8 * c8) = nk; *(u32x4*)(Raw + 1 * RT + lp * RLD + 8 * c8) = nv;
        { const size_t off = (size_t)(SCAN_R0(1) + sgn * lp) * 1024 + col; nk = *(const u32x4*)(fpl + off); nv = *(const u32x4*)(ipl + off); }
        __syncthreads();
        for (int c = 0; c < 72; ++c) {
            const bool need_o = c >= 8;
            const bf16_t* raw = Raw + (c & 1) * 3 * RT;
            float kk[8], loc[8]; unsigned vb[8]; float qv[8];
            {
                float f[8];
#pragma unroll
                for (int i = 0; i < 8; ++i) { kk[i] = bf2f(raw[(8 * pg + i) * RLD + ch]); f[i] = 1.0f - kk[i]; vb[i] = raw[RT + (8 * pg + i) * RLD + ch]; qv[i] = need_o ? bf2f(raw[2 * RT + (8 * pg + i) * RLD + ch]) : 0.f; }
                float s = 1.0f;
                if (pg < 2) {
#pragma unroll
                    for (int i = 7; i >= 0; --i) { loc[i] = s; s *= f[i]; }
                } else {
#pragma unroll
                    for (int i = 0; i < 8; ++i) { s *= f[i]; loc[i] = s; }
                }
                Pt[pg * 128 + ch] = s;
            }
            __syncthreads();
            {
                const float P0 = Pt[ch], P1 = Pt[128 + ch], P2 = Pt[256 + ch], P3 = Pt[384 + ch];
                const float T1 = P0 * P1, T2 = P2 * P3;
                const float mult = pg == 0 ? P1 : (pg == 3 ? P2 : 1.0f);
                float kh[8], qh[8], qt[8], kt[8];
#pragma unroll
                for (int i = 0; i < 8; ++i) {
                    const float X = loc[i] * mult; const float rX = __builtin_amdgcn_rcpf(X);
                    const float up = pg < 2 ? rX : X, dn = pg < 2 ? X : rX;
                    qt[i] = qv[i] * up; kt[i] = kk[i] * dn; qh[i] = qt[i] * T1; kh[i] = kt[i] * T2;
                }
                *(u32x4*)(KhT + ch * 40 + 8 * pg) = (u32x4){pk2(kh[0], kh[1]), pk2(kh[2], kh[3]), pk2(kh[4], kh[5]), pk2(kh[6], kh[7])};
                *(u32x4*)(VT + ch * 40 + 8 * pg) = (u32x4){vb[0] | (vb[1] << 16), vb[2] | (vb[3] << 16), vb[4] | (vb[5] << 16), vb[6] | (vb[7] << 16)};
                if (pg == 0) EG[ch] = T1 * T2;
                if (need_o) {
#pragma unroll
                    for (int i = 0; i < 8; i += 2) {
                        const unsigned a = pk2(qh[i], qh[i + 1]), b2 = pk2(qt[i], qt[i + 1]), c2 = pk2(kt[i], kt[i + 1]);
                        Qh[(8 * pg + i) * RLD + ch] = (bf16_t)a; Qh[(8 * pg + i + 1) * RLD + ch] = (bf16_t)(a >> 16);
                        Qt[(8 * pg + i) * RLD + ch] = (bf16_t)b2; Qt[(8 * pg + i + 1) * RLD + ch] = (bf16_t)(b2 >> 16);
                        Kt[(8 * pg + i) * RLD + ch] = (bf16_t)c2; Kt[(8 * pg + i + 1) * RLD + ch] = (bf16_t)(c2 >> 16);
                    }
                }
            }
            if (c > 8) *(u32x4*)(fpl + (size_t)(SCAN_R0(c - 1) + sgn * lp) * 1024 + col) = *(const u32x4*)(Os + lp * RLD + 8 * c8);
            __syncthreads();
            if (c + 1 < 72) {
                bf16_t* rn = Raw + ((c + 1) & 1) * 3 * RT + lp * RLD + 8 * c8;
                *(u32x4*)rn = nk; *(u32x4*)(rn + RT) = nv; if (c + 1 >= 8) *(u32x4*)(rn + 2 * RT) = nq;
                if (c + 2 < 72) {
                    const size_t off = (size_t)(SCAN_R0(c + 2) + sgn * lp) * 1024 + col;
                    nk = *(const u32x4*)(fpl + off); nv = *(const u32x4*)(ipl + off); if (c + 2 >= 8) nq = *(const u32x4*)(qpl + off);
                }
            }
            const bf16x8 bv = *(const bf16x8*)(VT + (16 * w + l15) * 40 + 8 * g);
            f32x4 o[2]; o[0] = (f32x4){0.f, 0.f, 0.f, 0.f}; o[1] = (f32x4){0.f, 0.f, 0.f, 0.f};
            if (need_o) {
#pragma unroll
                for (int ks = 0; ks < 4; ++ks) {
                    const bf16x8 sb = mkfrag(pk2(S[2 * ks][0], S[2 * ks][1]), pk2(S[2 * ks][2], S[2 * ks][3]), pk2(S[2 * ks + 1][0], S[2 * ks + 1][1]), pk2(S[2 * ks + 1][2], S[2 * ks + 1][3]));
#pragma unroll
                    for (int mt = 0; mt < 2; ++mt) {
                        const bf16_t* ap = Qh + (16 * mt + l15) * RLD + 32 * ks + 4 * g;
                        const u32x2 lo = *(const u32x2*)ap, hi = *(const u32x2*)(ap + 16);
                        o[mt] = MFMA16(mkfrag(lo.x, lo.y, hi.x, hi.y), sb, o[mt]);
                    }
                }
                if (w < 4) {
                    const int tm = w >> 1, sn = w & 1; f32x4 a = {0.f, 0.f, 0.f, 0.f};
                    if (!(tm == 0 && sn == 1)) {
#pragma unroll
                        for (int ks = 0; ks < 4; ++ks) {
                            const bf16x8 af = *(const bf16x8*)(Qt + (16 * tm + l15) * RLD + 32 * ks + 8 * g);
                            const bf16x8 bf = *(const bf16x8*)(Kt + (16 * sn + l15) * RLD + 32 * ks + 8 * g);
                            a = MFMA16(af, bf, a);
                        }
                    }
                    const int s_ = 16 * sn + l15;
#pragma unroll
                    for (int j = 0; j < 4; ++j) { const int t_ = 16 * tm + 4 * g + j; Am[t_ * 40 + s_] = f2bf(s_ <= t_ ? a[j] : 0.f); }
                }
            }
            __syncthreads();
            if (need_o) {
#pragma unroll
                for (int mt = 0; mt < 2; ++mt) { const bf16x8 af = *(const bf16x8*)(Am + (16 * mt + l15) * 40 + 8 * g); o[mt] = MFMA16(af, bv, o[mt]); }
#pragma unroll
                for (int mt = 0; mt < 2; ++mt)
#pragma unroll
                    for (int j = 0; j < 4; ++j) Os[(16 * mt + 4 * g + j) * RLD + 16 * w + l15] = f2bf(o[mt][j]);
            }
#pragma unroll
            for (int m = 0; m < 8; ++m) {
                const f32x4 eg = *(const f32x4*)(EG + 16 * m + 4 * g);
                const bf16x8 af = *(const bf16x8*)(KhT + (16 * m + l15) * 40 + 8 * g);
                S[m] = MFMA16(af, bv, S[m] * eg);
            }
        }
        __syncthreads();
        *(u32x4*)(fpl + (size_t)(SCAN_R0(71) + sgn * lp) * 1024 + col) = *(const u32x4*)(Os + lp * RLD + 8 * c8);
#undef SCAN_R0
    }
    __syncthreads();
}

__device__ __forceinline__ void grid_bar(unsigned* cnt, unsigned target, const int mk_wid) {
    __syncthreads();
    if (mk_tid(mk_wid) == 0) {
        __builtin_amdgcn_fence(__ATOMIC_RELEASE, "agent");
        __hip_atomic_fetch_add(cnt, 1u, __ATOMIC_RELAXED, __HIP_MEMORY_SCOPE_AGENT);
        while (__hip_atomic_load(cnt, __ATOMIC_RELAXED, __HIP_MEMORY_SCOPE_AGENT) < target) __builtin_amdgcn_s_sleep(8);
        __builtin_amdgcn_fence(__ATOMIC_ACQUIRE, "agent");
    }
    __syncthreads();
}
#define XB_TMO      128
#define XB_XCNT(j)  (256  + 64 * (j))
#define XB_XSUB(j)  (1280 + 64 * (j))
#define XB_XGEN(j)  (2304 + 64 * (j))
#define XB_TOP      3328
#define XB_TOPGEN   3392
#define XCD_BAR_WORDS 3456
#define XB_SPIN_CAP (1u << 18)
#define LAS __attribute__((address_space(3)))

__device__ __forceinline__ unsigned xb_ld(unsigned* p)              { return __hip_atomic_load(p, __ATOMIC_RELAXED, __HIP_MEMORY_SCOPE_AGENT); }
__device__ __forceinline__ unsigned xb_add(unsigned* p, unsigned v) { return __hip_atomic_fetch_add(p, v, __ATOMIC_RELAXED, __HIP_MEMORY_SCOPE_AGENT); }
__device__ __forceinline__ unsigned xb_xcc_id() { return (unsigned)__builtin_amdgcn_s_getreg((3 << 11) | 20) & 0xFu; }
#define XB_SPIN(cond, bar) do { unsigned _sp = 0; while (cond) { __builtin_amdgcn_s_sleep(1); \
    if ((++_sp & 255u) == 0u) { if (xb_ld(&(bar)[XB_TMO])) break; if (_sp > XB_SPIN_CAP) { atomicAdd(&(bar)[XB_TMO], 1u); break; } } } } while (0)

struct XcdBarrier {
    unsigned* bar; unsigned x;
    volatile LAS unsigned* st;
};

__device__ __forceinline__ XcdBarrier xcd_barrier_post(unsigned* bar, volatile LAS unsigned* st, const int mk_wid) {
    XcdBarrier b; b.bar = bar; b.x = xb_xcc_id(); b.st = st;
    if (mk_tid(mk_wid) == 0) (void)xb_add(&bar[XB_XCNT(b.x)], 1u);
    return b;
}
__device__ __forceinline__ void xcd_barrier_complete(unsigned* bar, unsigned x, unsigned& nloc, unsigned& nx) {
    const unsigned G = gridDim.x * gridDim.y * gridDim.z;
    unsigned sum, cnt, mine, sp = 0u;
    for (;;) {
        sum = 0u; cnt = 0u; mine = 0u;
#pragma unroll
        for (unsigned j = 0; j < 16; ++j) { const unsigned c = xb_ld(&bar[XB_XCNT(j)]); sum += c; cnt += (c > 0u) ? 1u : 0u; mine = (j == x) ? c : mine; }
        if (sum == G) break;
        __builtin_amdgcn_s_sleep(1);
        if ((++sp & 255u) == 0u) { if (xb_ld(&bar[XB_TMO])) break; if (sp > XB_SPIN_CAP) { atomicAdd(&bar[XB_TMO], 1u); break; } }
    }
    nloc = mine > 0u ? mine : 1u; nx = cnt > 0u ? cnt : 1u;
}

__device__ __forceinline__ void xcd_barrier(const XcdBarrier& b, const int mk_wid) {
    asm volatile("s_waitcnt vmcnt(0)" ::: "memory");
    __syncthreads();
    if (mk_tid(mk_wid) == 0) {
        unsigned* bar = b.bar;
        __builtin_amdgcn_s_waitcnt(0);
        unsigned nloc = b.st[0], nx = b.st[1];
        if (nloc == 0u) { xcd_barrier_complete(bar, b.x, nloc, nx); b.st[0] = nloc; b.st[1] = nx; }
        const unsigned old = xb_add(&bar[XB_XSUB(b.x)], 1u);
        const unsigned gen = old / nloc;
        if (old + 1u == (gen + 1u) * nloc) {
            __builtin_amdgcn_fence(__ATOMIC_RELEASE, "agent");
            asm volatile("s_waitcnt vmcnt(0)" ::: "memory");
            const unsigned og = xb_add(&bar[XB_TOP], 1u);
            const unsigned tg = og / nx;
            if (og + 1u == (tg + 1u) * nx) xb_add(&bar[XB_TOPGEN], 1u);
            else XB_SPIN(xb_ld(&bar[XB_TOPGEN]) == tg, bar);
            __builtin_amdgcn_fence(__ATOMIC_ACQUIRE, "agent");
            xb_add(&bar[XB_XGEN(b.x)], 1u);
            asm volatile("s_waitcnt vmcnt(0)" ::: "memory");
        } else {
            XB_SPIN(xb_ld(&bar[XB_XGEN(b.x)]) == gen, bar);
            __builtin_amdgcn_fence(__ATOMIC_ACQUIRE, "agent");
            asm volatile("s_waitcnt vmcnt(0)" ::: "memory");
        }
    }
    __syncthreads();
}


__global__ void __launch_bounds__(512) mk_fwd(Params P) {
    extern __shared__ __attribute__((aligned(16))) unsigned char lds_raw[];
    cg::grid_group grid = cg::this_grid();
    const int mk_wid = __builtin_amdgcn_readfirstlane((int)(threadIdx.x >> 6));
    PG8_LAS unsigned char* ldsg = (PG8_LAS unsigned char*)lds_raw;
    unsigned char* ws = P.ws;
    bf16_t* bt = (bf16_t*)(ws + WS_BT); float* hctx = (float*)(ws + WS_HCTX); bf16_t* xn = (bf16_t*)(ws + WS_XN);
    float* small = (float*)(ws + WS_SMALL); bf16_t* big = (bf16_t*)(ws + WS_BIG);
    const float* x = P.in[0]; const float* ctx = P.in[2]; const float* norm_g = P.in[6]; float* hl = P.out;
    const float* mod0 = small + SM_MOD; const float* mod1 = small + SM_MOD + 17 * NMOD;
#define IN(k) (P.ph_lo <= (k) && (k) < P.ph_hi)
#if PROBE_MASK
    unsigned long long ptot = 0, ptprev = __builtin_amdgcn_s_memrealtime();
#define PROBE_TICK(k) do { const unsigned long long now_ = __builtin_amdgcn_s_memrealtime(); if ((PROBE_MASK >> (k)) & 1) ptot += now_ - ptprev; ptprev = now_; } while (0)
#else
#define PROBE_TICK(k) do { } while (0)
#endif
    if (P.ph_lo < 0) grid.sync();
    { volatile PG8_LAS unsigned* st0 = (volatile PG8_LAS unsigned*)(ldsg + 131072); if (mk_tid(mk_wid) < 4) st0[mk_tid(mk_wid)] = 0u; }
    __syncthreads();
    XcdBarrier xbar = xcd_barrier_post((unsigned*)(ws + WS_BAR), (volatile PG8_LAS unsigned*)(ldsg + 131072), mk_wid);
#define SEAM(k) do { if (P.ph_lo <= (k) && (k) + 1 < P.ph_hi) xcd_barrier(xbar, mk_wid); PROBE_TICK(k); } while (0)

    bf16_t* xn2 = (bf16_t*)(ws + WS_XN2); float* rss = small + SM_RSS;
    const float* gam = small + SM_GAM;
    float* cparts = (float*)(ws + WS_BIG + 272 * MiB);
    const NormFix nfA{rss, small + SM_BIAS_UPA, 2 * DFF}, nfB{rss, small + SM_BIAS_UPB, 2 * DFF}, nfM0{rss, small + SM_BIAS_MIX, 2048}, nfM1{rss, small + SM_BIAS_MIX, 5120};
    if (IN(0)) mod_phase(lds_raw, P, mk_wid); SEAM(0);
    if (IN(1)) { prep_weights(lds_raw, P, 0, mk_wid); pool_fold(lds_raw, P, mk_wid); bias_phase(lds_raw, P, 0, mk_wid); prenorm_phase(x, ctx, norm_g, mod0, 1, xn, rss, T, mk_wid);
    } SEAM(1);
    if (IN(2)) { EpiSwiGLU E{big, nfA}; run_gemm(ldsg, xn, bt + BT_W13A, T, 2 * DFF, D, E, mk_wid); } SEAM(2);
    if (IN(3)) { EpiRes<true> E{x, hctx, hl, hctx, mod0 + 2 * 1024, gam + 1 * 17 * 1024, xn, rss, cparts, 0.5f, mk_wid}; run_gemm_split(ldsg, big, bt + BT_W2A, D, DFF, E, mk_wid); } SEAM(3);
    if (IN(3)) { ctx_emit_phase(ctx, hctx, cparts, gam + (1 * 17 + 16) * 1024, xn, rss, mk_wid); xcd_barrier(xbar, mk_wid); }
    if (IN(4)) { EpiAB E{big, nfM0}; run_gemm(ldsg, xn, bt + BT_MIXIN, T, 2048, D, E, mk_wid); } SEAM(4);
    if (IN(5)) mixer_ab_phase(lds_raw, P, mk_wid); SEAM(5);
    if (IN(6)) { EpiRes<true> E{hl, hctx, hl, hctx, mod0 + 5 * 1024, gam + 2 * 17 * 1024, xn2, rss, cparts, 1.0f, mk_wid}; run_gemm_split(ldsg, xn, bt + BT_MIXOUT, D, D, E, mk_wid); } SEAM(6);
    if (IN(6)) { ctx_emit_phase(hctx, hctx, cparts, gam + (2 * 17 + 16) * 1024, xn2, rss, mk_wid); xcd_barrier(xbar, mk_wid); }
    if (IN(7)) { EpiSwiGLU E{big, nfB}; run_gemm(ldsg, xn2, bt + BT_W13B, T, 2 * DFF, D, E, mk_wid); } SEAM(7);
    if (IN(8)) { EpiRes<true> E{hl, hctx, hl, hctx, mod0 + 8 * 1024, gam + 3 * 17 * 1024, xn, rss, cparts, 0.5f, mk_wid}; run_gemm_split(ldsg, big, bt + BT_W2B, D, DFF, E, mk_wid);  prep_weights(lds_raw, P, 1, mk_wid, 0, 1264, 0); bias_phase(lds_raw, P, 1, mk_wid, 0); } SEAM(8);
    if (IN(9)) { prep_weights(lds_raw, P, 1, mk_wid, 1264, 1440, 0); ctx_emit_phase(hctx, hctx, cparts, gam + (3 * 17 + 16) * 1024, xn, rss, mk_wid); } SEAM(9);
    if (IN(10)) { EpiSwiGLU E{big, nfA}; run_gemm(ldsg, xn, bt + BT_W13A, T, 2 * DFF, D, E, mk_wid); } SEAM(10);
    if (IN(11)) { EpiRes<true> E{hl, hctx, hl, hctx, mod1 + 2 * 1024, gam + 4 * 17 * 1024, xn, rss, cparts, 0.5f, mk_wid}; run_gemm_split(ldsg, big, bt + BT_W2A, D, DFF, E, mk_wid); } SEAM(11);
    if (IN(11)) { ctx_emit_phase(hctx, hctx, cparts, gam + (4 * 17 + 16) * 1024, xn, rss, mk_wid); xcd_barrier(xbar, mk_wid); }
    if (IN(12)) { EpiHG E{big, nfM1, small + SM_LB}; run_gemm_hg(ldsg, xn, bt + BT_MIXIN, E, mk_wid); } SEAM(12);
    if (IN(13)) scan_phase(lds_raw, P, mk_wid); SEAM(13);
    if (IN(14)) readout_phase(big, P.in[16], xn, mk_wid); SEAM(14);
    if (IN(15)) { EpiRes<true> E{hl, hctx, hl, hctx, mod1 + 5 * 1024, gam + 5 * 17 * 1024, xn2, rss, cparts, 1.0f, mk_wid}; run_gemm(ldsg, xn, bt + BT_MIXOUT, NLAT, D, D, E, mk_wid); } SEAM(15);
    if (IN(16)) { EpiSwiGLU E{big, nfB}; run_gemm(ldsg, xn2, bt + BT_W13B, NLAT, 2 * DFF, D, E, mk_wid); } SEAM(16);
    if (IN(17)) { EpiRes<false> E{hl, hctx, hl, hctx, mod1 + 8 * 1024, nullptr, nullptr, nullptr, cparts, 0.5f, mk_wid}; run_gemm(ldsg, big, bt + BT_W2B, NLAT, D, DFF, E, mk_wid); } SEAM(17);
    if (IN(18)) final_norm_phase(hl, P.in[18], mk_wid);
#if PROBE_MASK
    PROBE_TICK(18);
    if (blockIdx.x == 0) { const unsigned long long tend = __builtin_amdgcn_s_memrealtime(); while (__builtin_amdgcn_s_memrealtime() - tend < (unsigned long long)PROBE_K * ptot) __builtin_amdgcn_s_sleep(32); }
#endif
#undef IN
#undef SEAM
}
}

extern "C" void kernel_launch(void* const* d_in, const int* in_sizes, int n_in, void* d_out, int out_size, void* d_ws, size_t ws_size, hipStream_t stream) {
    static int grid = 0;
    if (grid == 0) {
        if (n_in != 19 || ws_size < mk::WS_END) { fprintf(stderr, "kernel_launch: unexpected n_in %d or ws_size %zu (need %zu)\n", n_in, ws_size, (size_t)mk::WS_END); grid = -1; return; }
        int dev = 0, cus = 0, per_cu = 0;
        hipGetDevice(&dev); hipDeviceGetAttribute(&cus, hipDeviceAttributeMultiprocessorCount, dev);
        if (hipFuncSetAttribute((const void*)mk::mk_fwd, hipFuncAttributeMaxDynamicSharedMemorySize, mk::LDS_BYTES) != hipSuccess) { fprintf(stderr, "kernel_launch: hipFuncSetAttribute failed\n"); grid = -1; return; }
        if (hipOccupancyMaxActiveBlocksPerMultiprocessor(&per_cu, (const void*)mk::mk_fwd, 512, mk::LDS_BYTES) != hipSuccess || per_cu < 1) { per_cu = 1; (void)hipGetLastError(); }
        grid = cus * 1;
        (void)per_cu;
    }
    if (grid < 0) return;
    (void)hipMemsetAsync((char*)d_ws + mk::WS_BAR, 0, 16384, stream);
    mk::Params p{};
    for (int i = 0; i < 19; ++i) p.in[i] = (const float*)d_in[i];
    p.out = (float*)d_out; p.ws = (unsigned char*)d_ws;
#if MK_PER_PHASE
    for (int ph = 0; ph < mk::NPHASE; ++ph) {
        p.ph_lo = ph; p.ph_hi = ph + 1; void* args[] = {&p};
        hipError_t e = hipLaunchCooperativeKernel((const void*)mk::mk_fwd, dim3(grid), dim3(512), args, mk::LDS_BYTES, stream);
        if (e != hipSuccess) { fprintf(stderr, "cooperative launch failed: %s\n", hipGetErrorString(e)); break; }
    }
#else
    p.ph_lo = 0; p.ph_hi = mk::NPHASE; void* args[] = {&p};
    hipError_t e = hipLaunchCooperativeKernel((const void*)mk::mk_fwd, dim3(grid), dim3(512), args, mk::LDS_BYTES, stream);
    if (e != hipSuccess) fprintf(stderr, "cooperative launch failed: %s (grid %d)\n", hipGetErrorString(e), grid);
#endif
}
```
